# Optimizing an MI355X kernel written in HIP

```python
import jax, jax.numpy as jnp
from jax import lax
import numpy as np

D_MODEL = 1024
BATCH = 32
SEQ = 2048
DEPTH = 1

CHUNK = 64
CONV_WIDTH = 3
CONV_DIM = D_MODEL // 2
CONV_GROUPS = 8
RET_HEADS = 4
RET_DIM = D_MODEL - CONV_DIM
RET_HEAD_DIM = RET_DIM // RET_HEADS
MIX_DIM = CONV_DIM + RET_DIM
IN_DIM = 3 * CONV_DIM + 4 * RET_DIM
D_FF = 4 * D_MODEL
ROPE_BASE = 10000.0
DECAY_OFFSET = 5.0
EPS = 1e-6
N_MOD = 6

kernel_name = 'hybrid_shortconv_retention_sandwich_adaln'


def rms_norm(x, g):
    xf = x.astype(jnp.float32)
    y = xf * lax.rsqrt(jnp.mean(xf * xf, axis=-1, keepdims=True) + EPS)
    return (y * g.astype(jnp.float32)).astype(x.dtype)


def rotary(t, positions):
    half = t.shape[-1] // 2
    inv_freq = ROPE_BASE ** (-jnp.arange(half, dtype=jnp.float32) / half)
    ang = positions.astype(jnp.float32)[..., None] * inv_freq
    cos = jnp.cos(ang)[:, :, None, :]
    sin = jnp.sin(ang)[:, :, None, :]
    tf = t.astype(jnp.float32)
    t1, t2 = tf[..., :half], tf[..., half:]
    out = jnp.concatenate([t1 * cos - t2 * sin, t2 * cos + t1 * sin], axis=-1)
    return out.astype(t.dtype)


def short_conv_mixer(xin, b_gate, c_gate, conv_w):
    S = xin.shape[1]
    u = c_gate * xin
    up = jnp.pad(u, ((0, 0), (CONV_WIDTH - 1, 0), (0, 0)))
    y = up[:, 0:S] * conv_w[0]
    for j in range(1, CONV_WIDTH):
        y = y + up[:, j:j + S] * conv_w[j]
    return b_gate * y


def retention_mixer(q, k, v, g, positions):
    B, S, _ = q.shape
    H, dh, C = RET_HEADS, RET_HEAD_DIM, CHUNK
    NC = S // C
    dt = q.dtype
    q = rotary(q.reshape(B, S, H, dh), positions)
    k = rotary(k.reshape(B, S, H, dh), positions) * (dh ** -0.5)
    v = v.reshape(B, S, H, dh)

    def to_chunks(t):
        return t.reshape(B, NC, C, H, dh).transpose(0, 3, 1, 2, 4)

    q, k, v = to_chunks(q), to_chunks(k), to_chunks(v)

    log_gamma = jnp.log1p(-jnp.exp2(-DECAY_OFFSET - jnp.arange(H, dtype=jnp.float32)))
    idx = jnp.arange(C, dtype=jnp.float32)
    intra_dec = jnp.exp(log_gamma[:, None, None] * jnp.abs(idx[:, None] - idx[None, :]))
    q_dec = jnp.exp(log_gamma[:, None] * (idx + 1.0))
    k_dec = jnp.exp(log_gamma[:, None] * (C - 1.0 - idx))
    chunk_dec = jnp.exp(log_gamma * C)

    scores = jnp.einsum('bhncd,bhnmd->bhncm', q, k) * intra_dec[:, None].astype(dt)
    o_intra = jnp.einsum('bhncm,bhnmd->bhncd', scores, v)

    kv = jnp.einsum('bhnmd,bhnme->nbhde', k * k_dec[:, None, :, None].astype(dt), v)
    kv = kv.astype(jnp.float32)

    def step(state, kv_n):
        return state * chunk_dec[:, None, None] + kv_n, state

    _, s_prev = lax.scan(step, jnp.zeros((B, H, dh, dh), jnp.float32), kv)
    o_cross = jnp.einsum('bhncd,nbhde->bhnce',
                         q * q_dec[:, None, :, None].astype(dt), s_prev.astype(dt))

    o = (o_intra + o_cross).transpose(0, 2, 3, 1, 4).reshape(B, S, H, dh)
    of = o.astype(jnp.float32)
    of = of * lax.rsqrt(jnp.mean(of * of, axis=-1, keepdims=True) + EPS)
    o = of.astype(dt).reshape(B, S, RET_DIM)
    return jax.nn.silu(g) * o


def setup_inputs(seed: int = 0) -> dict:
    key = jax.random.key(seed)
    ks = jax.random.split(key, 16)
    f32 = jnp.float32
    x = jax.random.normal(ks[0], (BATCH, SEQ, D_MODEL), f32)
    c = jax.random.normal(ks[1], (BATCH, D_MODEL), f32)
    offset = jax.random.randint(ks[2], (BATCH, 1), 0, 4096, dtype=jnp.int32)
    positions = offset + jnp.arange(SEQ, dtype=jnp.int32)[None, :]
    w_ada = jax.random.normal(ks[3], (DEPTH, D_MODEL, N_MOD * D_MODEL), f32) * (0.5 * D_MODEL ** -0.5)
    b_ada = jax.random.normal(ks[4], (DEPTH, N_MOD * D_MODEL), f32) * 0.01
    g_pre_mix = 1.0 + 0.05 * jax.random.normal(ks[5], (DEPTH, D_MODEL), f32)
    g_post_mix = 1.0 + 0.05 * jax.random.normal(ks[6], (DEPTH, D_MODEL), f32)
    w_in = jax.random.normal(ks[7], (DEPTH, D_MODEL, IN_DIM), f32) * D_MODEL ** -0.5
    conv_w = jax.random.normal(ks[8], (DEPTH, CONV_WIDTH, CONV_DIM), f32) * CONV_WIDTH ** -0.5
    w_out = jax.random.normal(ks[9], (DEPTH, MIX_DIM, D_MODEL), f32) * MIX_DIM ** -0.5
    g_pre_mlp = 1.0 + 0.05 * jax.random.normal(ks[10], (DEPTH, D_MODEL), f32)
    g_post_mlp = 1.0 + 0.05 * jax.random.normal(ks[11], (DEPTH, D_MODEL), f32)
    w_fc1 = jax.random.normal(ks[12], (DEPTH, D_MODEL, D_FF), f32) * D_MODEL ** -0.5
    w_fc2 = jax.random.normal(ks[13], (DEPTH, D_FF, D_MODEL), f32) * D_FF ** -0.5
    return {'x': x, 'c': c, 'positions': positions, 'w_ada': w_ada, 'b_ada': b_ada,
            'g_pre_mix': g_pre_mix, 'g_post_mix': g_post_mix, 'w_in': w_in,
            'conv_w': conv_w, 'w_out': w_out, 'g_pre_mlp': g_pre_mlp,
            'g_post_mlp': g_post_mlp, 'w_fc1': w_fc1, 'w_fc2': w_fc2}


def reference(x, c, positions, w_ada, b_ada, g_pre_mix, g_post_mix, w_in, conv_w,
              w_out, g_pre_mlp, g_post_mlp, w_fc1, w_fc2):
    split_at = [CONV_DIM, 2 * CONV_DIM, 3 * CONV_DIM,
                3 * CONV_DIM + RET_DIM, 3 * CONV_DIM + 2 * RET_DIM, 3 * CONV_DIM + 3 * RET_DIM]
    for layer in range(DEPTH):
        mod = jax.nn.silu(c) @ w_ada[layer] + b_ada[layer]
        shift1, scale1, gate1, shift2, scale2, gate2 = [
            m[:, None, :] for m in jnp.split(mod, N_MOD, axis=-1)]

        h = rms_norm(x, g_pre_mix[layer]) * (1.0 + scale1) + shift1
        proj = h @ w_in[layer]
        xin, b_gate, c_gate, q, k, v, g = jnp.split(proj, split_at, axis=-1)
        y_conv = short_conv_mixer(xin, b_gate, c_gate, conv_w[layer])
        y_ret = retention_mixer(q, k, v, g, positions)
        mix = jnp.concatenate([y_conv, y_ret], axis=-1) @ w_out[layer]
        x = x + gate1 * rms_norm(mix, g_post_mix[layer])

        h = rms_norm(x, g_pre_mlp[layer]) * (1.0 + scale2) + shift2
        f = jnp.square(jax.nn.relu(h @ w_fc1[layer])) @ w_fc2[layer]
        x = x + gate2 * rms_norm(f, g_post_mlp[layer])
    return x
```

```cpp
#include <hip/hip_runtime.h>
#include <hip/hip_cooperative_groups.h>
namespace cg = cooperative_groups;
#include <cstdio>
#include <cstdint>

#define GAS __attribute__((address_space(1)))
#define LAS __attribute__((address_space(3)))
typedef unsigned short bf16;
typedef unsigned v4u __attribute__((ext_vector_type(4)));
typedef unsigned v2u __attribute__((ext_vector_type(2)));
typedef float f32x4 __attribute__((ext_vector_type(4)));
typedef short bf16x8 __attribute__((ext_vector_type(8)));

constexpr int BATCH = 32, SEQ = 2048, D = 1024, M = BATCH * SEQ, CONV = 512, RET = 512, HEADS = 4, DH = 128, CH = 64;
constexpr int IN_DIM = 3584, FF = 4096, NMOD = 6144, NCHUNK = SEQ / CH;
constexpr int OFF_XIN = 0, OFF_B = 512, OFF_C = 1024, OFF_Q = 1536, OFF_K = 2048, OFF_V = 2560, OFF_G = 3072;
constexpr float EPS = 1e-6f;
constexpr int KS_MOD = 8;

constexpr size_t MiB = 1u << 20;
constexpr size_t WS_CTL = 0;
constexpr size_t WS_MODP = 2 * MiB;
constexpr size_t WS_MOD = 10 * MiB;
constexpr size_t WS_WIN = 12 * MiB;
constexpr size_t WS_WOUT = 20 * MiB;
constexpr size_t WS_W1 = 22 * MiB;
constexpr size_t WS_W2 = 30 * MiB;
constexpr size_t WS_H = 64 * MiB;
constexpr size_t WS_BIG = 192 * MiB;
constexpr size_t WS_MIXIN = 704 * MiB;
constexpr size_t WS_MIX = 832 * MiB;
constexpr size_t WS_END = 960 * MiB;

__device__ __forceinline__ unsigned f2bf(float f) { unsigned u = __builtin_bit_cast(unsigned, f); return (u + 0x7fffu + ((u >> 16) & 1u)) >> 16; }
typedef __bf16 bfv2 __attribute__((ext_vector_type(2)));
typedef float f32x2 __attribute__((ext_vector_type(2)));
__device__ __forceinline__ unsigned pk2(float lo, float hi) { return __builtin_bit_cast(unsigned, __builtin_convertvector((f32x2){lo, hi}, bfv2)); }
__device__ __forceinline__ float bf2f(unsigned short b) { return __builtin_bit_cast(float, ((unsigned)b) << 16); }
__device__ __forceinline__ float bflo(unsigned w) { return __builtin_bit_cast(float, w << 16); }
__device__ __forceinline__ float bfhi(unsigned w) { return __builtin_bit_cast(float, w & 0xffff0000u); }
#define LDS_WAIT() asm volatile("s_waitcnt lgkmcnt(0)" ::: "memory")

__device__ __forceinline__ float wave_sum(float v) {
#pragma unroll
    for (int o = 1; o < 64; o <<= 1) v += __shfl_xor(v, o);
    return v;
}
__device__ __forceinline__ float silu_f(float x) { return x / (1.f + expf(-x)); }
__device__ __forceinline__ float silu_fast(float x) { return x * __builtin_amdgcn_rcpf(1.0f + __builtin_amdgcn_exp2f(-1.4426950408889634f * x)); }

__device__ __forceinline__ void rope_cs(int pos, float invf, float& cs, float& sn) {
    const float ang = (float)pos * invf;
    const float k = __builtin_rintf(ang * 0.15915494309189535f);
    float r = __builtin_fmaf(-k, 6.2831854820251465f, ang);
    r = __builtin_fmaf(-k, -1.7484555e-07f, r);
    const float fr = r * 0.15915494309189535f;
    sn = __builtin_amdgcn_sinf(fr); cs = __builtin_amdgcn_cosf(fr);
}
__device__ __forceinline__ float inv_freq_of(int i) { return powf(10000.0f, -(float)i / 64.0f); }

struct Frame {
    LAS unsigned char* lds;
    int tid, lane, wave, vcu, G;
    const float *x, *c, *w_ada, *b_ada, *g_pre_mix, *g_post_mix, *w_in, *conv_w, *w_out, *g_pre_mlp, *g_post_mlp, *w_fc1, *w_fc2;
    const int* positions;
    float* out;
    float *modp, *mod, *invf_tab;
    bf16 *Win_t, *Wout_t, *W1_t, *W2_t, *H, *BIG, *MIXIN, *MIX, *CONVB, *RETB;
};

template <bool PERM_IN = false> __device__ __forceinline__ void p0_transpose_item(const float* W, int K, int N, bf16* WT, LAS float* scr, int item, int lane) {
    const int nblk = N / 32, kb = item / nblk, nb = item % nblk, k0 = 64 * kb, n0 = 32 * nb;
    const int s0 = !PERM_IN ? n0 : (n0 < 1024 ? (((n0 >> 5) & 1) ? 1024 : 0) + 128 * (n0 >> 8) + 32 * ((n0 & 255) >> 6) + (n0 & 31) : (n0 < 1536 ? n0 - 512 : n0));
#pragma unroll 8
    for (int i = 0; i < 32; ++i) { const int kk = 2 * i + (lane >> 5); scr[kk * 33 + (lane & 31)] = W[(size_t)(k0 + kk) * N + s0 + (lane & 31)]; }
    LDS_WAIT(); asm volatile("" ::: "memory");
    const int c = lane & 7;
#pragma unroll
    for (int j = 0; j < 4; ++j) { const int n = (lane >> 3) + 8 * j; const LAS float* s = scr + (8 * c) * 33 + n;
        v4u o; o.x = pk2(s[0 * 33], s[1 * 33]); o.y = pk2(s[2 * 33], s[3 * 33]); o.z = pk2(s[4 * 33], s[5 * 33]); o.w = pk2(s[6 * 33], s[7 * 33]);
        *(GAS v4u*)(WT + (size_t)(n0 + n) * K + k0 + 8 * c) = o; }
    LDS_WAIT(); asm volatile("" ::: "memory");
}
__device__ __forceinline__ void p0_mod_item(const Frame& F, int item, int lane) {
    const int cg = item % (NMOD / 64), ks = item / (NMOD / 64), k0 = ks * (D / KS_MOD), fr = lane & 15, kq = lane >> 4;
    constexpr int KK = D / KS_MOD;
    f32x4 acc[2][4];
#pragma unroll
    for (int mt = 0; mt < 2; ++mt)
#pragma unroll
        for (int nt = 0; nt < 4; ++nt) acc[mt][nt] = (f32x4){0.f, 0.f, 0.f, 0.f};
    const float* cp = F.c + (size_t)fr * D + k0 + kq;
    const float* wp = F.w_ada + (size_t)(k0 + kq) * NMOD + cg * 64 + fr;
    for (int s0 = 0; s0 < KK / 4; s0 += 8) {
        float av[8][2], bv[8][4];
#pragma unroll
        for (int s = 0; s < 8; ++s) {
#pragma unroll
            for (int mt = 0; mt < 2; ++mt) av[s][mt] = cp[(size_t)mt * 16 * D + 4 * (s0 + s)];
#pragma unroll
            for (int nt = 0; nt < 4; ++nt) bv[s][nt] = wp[(size_t)4 * (s0 + s) * NMOD + 16 * nt];
        }
#pragma unroll
        for (int s = 0; s < 8; ++s) {
            const float a0 = silu_fast(av[s][0]), a1 = silu_fast(av[s][1]);
#pragma unroll
            for (int nt = 0; nt < 4; ++nt) { acc[0][nt] = __builtin_amdgcn_mfma_f32_16x16x4f32(a0, bv[s][nt], acc[0][nt], 0, 0, 0);
                                             acc[1][nt] = __builtin_amdgcn_mfma_f32_16x16x4f32(a1, bv[s][nt], acc[1][nt], 0, 0, 0); }
        }
    }
#pragma unroll
    for (int mt = 0; mt < 2; ++mt)
#pragma unroll
        for (int nt = 0; nt < 4; ++nt)
#pragma unroll
            for (int r = 0; r < 4; ++r) F.modp[((size_t)ks * 32 + 16 * mt + 4 * kq + r) * NMOD + cg * 64 + 16 * nt + fr] = acc[mt][nt][r];
}
__device__ __forceinline__ void p0_prologue(const Frame& F) {
    LAS float* scr = (LAS float*)(F.lds + F.wave * 16384);
    if (F.vcu == 0 && F.tid < 64) F.invf_tab[F.tid] = inv_freq_of(F.tid);
    constexpr int I_MOD = (NMOD / 64) * KS_MOD;
    constexpr int I_IN = (D / 64) * (IN_DIM / 32), I_OUT = (D / 64) * (D / 32), I_1 = (D / 64) * (FF / 32), I_2 = (FF / 64) * (D / 32);
    constexpr int NITEMS = I_IN + I_OUT + I_1 + I_2;
    { const int per = (I_MOD + F.G - 1) / F.G; for (int w = F.wave; w < per; w += 8) { const int it = F.vcu * per + w; if (it < I_MOD) p0_mod_item(F, it, F.lane); } }
    const int gw = F.vcu * 8 + F.wave, NGW = F.G * 8;
    for (int it = gw; it < NITEMS; it += NGW) {
        int r = it;
        if (r < I_IN) { p0_transpose_item<true>(F.w_in, D, IN_DIM, F.Win_t, scr, r, F.lane); continue; } r -= I_IN;
        if (r < I_OUT) { p0_transpose_item(F.w_out, D, D, F.Wout_t, scr, r, F.lane); continue; } r -= I_OUT;
        if (r < I_1) { p0_transpose_item(F.w_fc1, D, FF, F.W1_t, scr, r, F.lane); continue; } r -= I_1;
        p0_transpose_item(F.w_fc2, FF, D, F.W2_t, scr, r, F.lane);
    }
}

__device__ __forceinline__ void p1_h1(const Frame& F) {
    LAS float* modl = (LAS float*)F.lds;
    for (int p = F.vcu; p < M / 256; p += F.G) {
        const int b = p >> 3;
        __syncthreads();
        {
            float s[5]; int jj[5];
#pragma unroll
            for (int q = 0; q < 4; ++q) jj[q] = F.tid + 512 * q;
            jj[4] = 2 * D + (p & 7) * 512 + F.tid;
#pragma unroll
            for (int q = 0; q < 5; ++q) s[q] = F.b_ada[jj[q]];
#pragma unroll
            for (int ks = 0; ks < KS_MOD; ++ks)
#pragma unroll
                for (int q = 0; q < 5; ++q) s[q] += F.modp[((size_t)ks * 32 + b) * NMOD + jj[q]];
#pragma unroll
            for (int q = 0; q < 4; ++q) { modl[jj[q]] = s[q]; if ((jj[q] >> 8) == (p & 7)) F.mod[(size_t)b * NMOD + jj[q]] = s[q]; }
            F.mod[(size_t)b * NMOD + jj[4]] = s[4];
        }
        __syncthreads();
        float a[16], sh[16];
#pragma unroll
        for (int j = 0; j < 4; ++j)
#pragma unroll
            for (int i = 0; i < 4; ++i) { const int col = 4 * (F.lane + 64 * j) + i; a[4 * j + i] = F.g_pre_mix[col] * (1.f + modl[D + col]); sh[4 * j + i] = modl[col]; }
        for (int r = 0; r < 32; ++r) {
            const size_t row = (size_t)p * 256 + F.wave * 32 + r;
            const GAS f32x4* xr = (const GAS f32x4*)(F.x + row * D) + F.lane;
            f32x4 v[4]; float s = 0.f;
#pragma unroll
            for (int j = 0; j < 4; ++j) { v[j] = __builtin_nontemporal_load(xr + 64 * j); s += (v[j].x * v[j].x + v[j].y * v[j].y) + (v[j].z * v[j].z + v[j].w * v[j].w); }
            const float rstd = 1.0f / sqrtf(wave_sum(s) * (1.f / D) + EPS);
            GAS v2u* o8 = (GAS v2u*)(F.H + row * D) + F.lane;
#pragma unroll
            for (int j = 0; j < 4; ++j) { v2u o; o.x = pk2(v[j].x * rstd * a[4 * j + 0] + sh[4 * j + 0], v[j].y * rstd * a[4 * j + 1] + sh[4 * j + 1]);
                o.y = pk2(v[j].z * rstd * a[4 * j + 2] + sh[4 * j + 2], v[j].w * rstd * a[4 * j + 3] + sh[4 * j + 3]); o8[64 * j] = o; }
        }
    }
}

__device__ __forceinline__ void conv_seg16(const Frame& F, int seg, int lane) {
    const bf16* P = F.CONVB;
    const int r0 = seg * 16, s0 = r0 & (SEQ - 1), ch = lane * 8;
    float w0[8], w1[8], w2[8], u1[8], u2[8];
#pragma unroll
    for (int i = 0; i < 8; ++i) { w0[i] = F.conv_w[ch + i]; w1[i] = F.conv_w[CONV + ch + i]; w2[i] = F.conv_w[2 * CONV + ch + i]; u1[i] = 0.f; u2[i] = 0.f; }
    if (s0 != 0) {
#pragma unroll
        for (int k = 0; k < 2; ++k) {
            const v4u uv = __builtin_nontemporal_load((const GAS v4u*)(P + (size_t)(r0 - 2 + k) * 1024 + ch));
            const unsigned uw[4] = {uv.x, uv.y, uv.z, uv.w};
#pragma unroll
            for (int i = 0; i < 4; ++i) { if (k == 0) { u2[2 * i] = bflo(uw[i]); u2[2 * i + 1] = bfhi(uw[i]); } else { u1[2 * i] = bflo(uw[i]); u1[2 * i + 1] = bfhi(uw[i]); } }
        }
    }
    for (int rb = 0; rb < 16; rb += 8) {
        v4u uv[8], bv[8];
#pragma unroll
        for (int r = 0; r < 8; ++r) { const size_t rr = (size_t)(r0 + rb + r) * 1024;
            uv[r] = __builtin_nontemporal_load((const GAS v4u*)(P + rr + ch)); bv[r] = __builtin_nontemporal_load((const GAS v4u*)(P + rr + 512 + ch)); }
#pragma unroll
        for (int r = 0; r < 8; ++r) {
            const unsigned uw[4] = {uv[r].x, uv[r].y, uv[r].z, uv[r].w}, bw[4] = {bv[r].x, bv[r].y, bv[r].z, bv[r].w};
            float y[8];
#pragma unroll
            for (int i = 0; i < 4; ++i) {
                const float ua = bflo(uw[i]), ub = bfhi(uw[i]);
                y[2 * i] = bflo(bw[i]) * (u2[2 * i] * w0[2 * i] + u1[2 * i] * w1[2 * i] + ua * w2[2 * i]);
                y[2 * i + 1] = bfhi(bw[i]) * (u2[2 * i + 1] * w0[2 * i + 1] + u1[2 * i + 1] * w1[2 * i + 1] + ub * w2[2 * i + 1]);
                u2[2 * i] = u1[2 * i]; u2[2 * i + 1] = u1[2 * i + 1]; u1[2 * i] = ua; u1[2 * i + 1] = ub;
            }
            v4u o; o.x = pk2(y[0], y[1]); o.y = pk2(y[2], y[3]); o.z = pk2(y[4], y[5]); o.w = pk2(y[6], y[7]);
            *(GAS v4u*)(F.MIXIN + (size_t)(r0 + rb + r) * D + ch) = o;
        }
    }
}

__device__ __forceinline__ void p5_postmix(const Frame& F) {
    for (int p = F.vcu; p < M / 256; p += F.G) {
        const int b = p >> 3; const float* mod = F.mod + (size_t)b * NMOD;
        float g1[16], a2[16], sh2[16];
#pragma unroll
        for (int j = 0; j < 4; ++j)
#pragma unroll
            for (int i = 0; i < 4; ++i) { const int col = 4 * (F.lane + 64 * j) + i; g1[4 * j + i] = mod[2 * D + col] * F.g_post_mix[col];
                a2[4 * j + i] = F.g_pre_mlp[col] * (1.f + mod[4 * D + col]); sh2[4 * j + i] = mod[3 * D + col]; }
        for (int r = 0; r < 32; ++r) {
            const size_t row = (size_t)p * 256 + F.wave * 32 + r;
            const GAS f32x4* xr = (const GAS f32x4*)(F.x + row * D) + F.lane;
            const GAS v2u* mr = (const GAS v2u*)(F.MIX + row * D) + F.lane;
            f32x4 xv[4], mv[4]; float s = 0.f;
#pragma unroll
            for (int j = 0; j < 4; ++j) { xv[j] = __builtin_nontemporal_load(xr + 64 * j); const v2u m2 = __builtin_nontemporal_load(mr + 64 * j); mv[j] = (f32x4){bflo(m2.x), bfhi(m2.x), bflo(m2.y), bfhi(m2.y)};
                s += (mv[j].x * mv[j].x + mv[j].y * mv[j].y) + (mv[j].z * mv[j].z + mv[j].w * mv[j].w); }
            const float rstd = 1.0f / sqrtf(wave_sum(s) * (1.f / D) + EPS);
            float s2 = 0.f;
#pragma unroll
            for (int j = 0; j < 4; ++j) { xv[j].x += mv[j].x * rstd * g1[4 * j + 0]; xv[j].y += mv[j].y * rstd * g1[4 * j + 1]; xv[j].z += mv[j].z * rstd * g1[4 * j + 2]; xv[j].w += mv[j].w * rstd * g1[4 * j + 3];
                s2 += (xv[j].x * xv[j].x + xv[j].y * xv[j].y) + (xv[j].z * xv[j].z + xv[j].w * xv[j].w); }
            const float rstd2 = 1.0f / sqrtf(wave_sum(s2) * (1.f / D) + EPS);
            GAS v2u* x1b = (GAS v2u*)(F.MIX + row * D) + F.lane;
            GAS v2u* o8 = (GAS v2u*)(F.H + row * D) + F.lane;
#pragma unroll
            for (int j = 0; j < 4; ++j) { v2u xb; xb.x = pk2(xv[j].x, xv[j].y); xb.y = pk2(xv[j].z, xv[j].w); __builtin_nontemporal_store(xb, x1b + 64 * j);
                v2u o; o.x = pk2(xv[j].x * rstd2 * a2[4 * j + 0] + sh2[4 * j + 0], xv[j].y * rstd2 * a2[4 * j + 1] + sh2[4 * j + 1]);
                o.y = pk2(xv[j].z * rstd2 * a2[4 * j + 2] + sh2[4 * j + 2], xv[j].w * rstd2 * a2[4 * j + 3] + sh2[4 * j + 3]); o8[64 * j] = o; }
        }
    }
}
__device__ __forceinline__ void p8_final(const Frame& F) {
    const bf16* Fm = F.MIXIN;
    for (int p = F.vcu; p < M / 256; p += F.G) {
        const int b = p >> 3; const float* mod = F.mod + (size_t)b * NMOD;
        float g2[16];
#pragma unroll
        for (int j = 0; j < 4; ++j)
#pragma unroll
            for (int i = 0; i < 4; ++i) { const int col = 4 * (F.lane + 64 * j) + i; g2[4 * j + i] = mod[5 * D + col] * F.g_post_mlp[col]; }
        for (int r = 0; r < 32; ++r) {
            const size_t row = (size_t)p * 256 + F.wave * 32 + r;
            GAS f32x4* orow = (GAS f32x4*)(F.out + row * D) + F.lane;
            const GAS v2u* mr = (const GAS v2u*)(Fm + row * D) + F.lane;
            const GAS v2u* x1r = (const GAS v2u*)(F.MIX + row * D) + F.lane;
            f32x4 xv[4], mv[4]; float s = 0.f;
#pragma unroll
            for (int j = 0; j < 4; ++j) { const v2u xb = __builtin_nontemporal_load(x1r + 64 * j); xv[j] = (f32x4){bflo(xb.x), bfhi(xb.x), bflo(xb.y), bfhi(xb.y)}; const v2u m2 = __builtin_nontemporal_load(mr + 64 * j); mv[j] = (f32x4){bflo(m2.x), bfhi(m2.x), bflo(m2.y), bfhi(m2.y)};
                s += (mv[j].x * mv[j].x + mv[j].y * mv[j].y) + (mv[j].z * mv[j].z + mv[j].w * mv[j].w); }
            const float rstd = 1.0f / sqrtf(wave_sum(s) * (1.f / D) + EPS);
#pragma unroll
            for (int j = 0; j < 4; ++j) { xv[j].x += mv[j].x * rstd * g2[4 * j + 0]; xv[j].y += mv[j].y * rstd * g2[4 * j + 1]; xv[j].z += mv[j].z * rstd * g2[4 * j + 2]; xv[j].w += mv[j].w * rstd * g2[4 * j + 3];
                __builtin_nontemporal_store(xv[j], orow + 64 * j); }
        }
    }
}


namespace pg8 {
#define PG8_LAS __attribute__((address_space(3)))
typedef unsigned short bf16_t;
typedef short bf16x8 __attribute__((ext_vector_type(8)));
typedef float f32x4 __attribute__((ext_vector_type(4)));
typedef unsigned u32x4 __attribute__((ext_vector_type(4)));
constexpr int BM = 256, BK = 64, HALF = 128, HTB = HALF * BK * 2  , STAGE_BYTES = 8 * HTB, NXCD = 8, WGM = 8;
__host__ __device__ __forceinline__ int lds_byte(int r, int c) { const int st = (r >> 4) * 2 + (c >> 5), rr = r & 15, cc = c & 31, ob = rr * 64 + cc * 2; return st * 1024 + (ob ^ (((ob >> 9) & 1) << 5)); }
__host__ __device__ __forceinline__ void stage_rc(int b, int& R, int& C) { const int st = b / 1024, sb = b % 1024, swz = sb ^ (((sb >> 9) & 1) << 5); R = (st >> 1) * 16 + swz / 64; C = (st & 1) * 32 + (swz % 64) / 2; }
__host__ __device__ __forceinline__ int perm32(int rho) { const int n = rho >> 4, i = rho & 15; return 8 * (i >> 2) + 4 * n + (i & 3); }
struct Unit { int pm, pn; };
struct Gemm { const bf16_t* A; const bf16_t* Bt; int M, N, K; };
struct StaticOrder {
    int nM, nN, nwg, G, c;
    __host__ __device__ void init(int M, int N, int G_, int c_) { nM = M / BM; nN = N / BM; nwg = nM * nN; G = G_; c = c_; }
    __host__ __device__ bool next(int i, Unit& u) const {
        const long L = (long)i * G + c; if (L >= nwg) return false;
        int wgid = (int)L; { const int q = nwg / NXCD, r = nwg % NXCD, xcd = wgid % NXCD, off = wgid / NXCD; wgid = (xcd < r ? xcd * (q + 1) : r * (q + 1) + (xcd - r) * q) + off; }
        const int nig = WGM * nN, gid = wgid / nig, fm = gid * WGM, gsz = (nM - fm) < WGM ? (nM - fm) : WGM;
        u.pm = fm + ((wgid % nig) % gsz); u.pn = (wgid % nig) / gsz; return true;
    }
    __device__ __forceinline__ void a_ready(const Unit&) const {}
    __device__ __forceinline__ void done(const Unit&) const {}
};
__device__ __forceinline__ unsigned cvt_pk_bf16(float lo, float hi) { unsigned r; asm volatile("v_cvt_pk_bf16_f32 %0, %1, %2" : "=v"(r) : "v"(lo), "v"(hi)); return r; }
__device__ __forceinline__ unsigned swap_pair(unsigned x) { return (unsigned)__builtin_amdgcn_mov_dpp((int)x, 0xB1, 0xF, 0xF, true); }
__device__ __forceinline__ u32x4 pack8(const f32x4 v0, const f32x4 v1) { u32x4 w; w.x = cvt_pk_bf16(v0[0], v0[1]); w.y = cvt_pk_bf16(v0[2], v0[3]); w.z = cvt_pk_bf16(v1[0], v1[1]); w.w = cvt_pk_bf16(v1[2], v1[3]); return w; }
__device__ __forceinline__ void pair_rows(const u32x4 w0, const u32x4 w1, bool odd, u32x4& ev, u32x4& od) {
    const u32x4 s0 = {swap_pair(w0.x), swap_pair(w0.y), swap_pair(w0.z), swap_pair(w0.w)}, s1 = {swap_pair(w1.x), swap_pair(w1.y), swap_pair(w1.z), swap_pair(w1.w)};
    ev = odd ? s1 : w0; od = odd ? w1 : s0;
}
template <int ACT  , bool NT = false  > struct EpiBf16 {
    static constexpr bool PERM = true, AFTER_DRAIN = false;
    bf16_t* O; int ldc;
    __device__ __forceinline__ void operator()(const f32x4 (&acc)[2][2][4][2], const Unit& u, int wr, int wc, int fr, int fq) const {
        const bool odd = fr & 1;
        bf16_t* base = O + (size_t)(u.pm * BM + wr * 64 + (fr & ~1)) * ldc + u.pn * BM + wc * 64 + (odd ? 32 : 0) + 8 * fq;
#pragma unroll
        for (int ai = 0; ai < 2; ++ai)
#pragma unroll
            for (int m = 0; m < 4; ++m) { bf16_t* rowp = base + (size_t)(ai * HALF + m * 16) * ldc;
                f32x4 v[2][2];
#pragma unroll
                for (int bj = 0; bj < 2; ++bj)
#pragma unroll
                    for (int n = 0; n < 2; ++n) { v[bj][n] = acc[ai][bj][m][n];
                        if (ACT == 2) {
#pragma unroll
                            for (int j = 0; j < 4; ++j) { const float a0 = v[bj][n][j] > 0.f ? v[bj][n][j] : 0.f; v[bj][n][j] = a0 * a0; } } }
                u32x4 ev, od; pair_rows(pack8(v[0][0], v[0][1]), pack8(v[1][0], v[1][1]), odd, ev, od);
                if (NT) { __builtin_nontemporal_store(ev, (u32x4*)rowp); __builtin_nontemporal_store(od, (u32x4*)(rowp + ldc)); }
                else { *(u32x4*)rowp = ev; *(u32x4*)(rowp + ldc) = od; } }
    }
};

__device__ __forceinline__ float silu_epi(float x) { return x * __builtin_amdgcn_rcpf(1.0f + __builtin_amdgcn_exp2f(-1.4426950408889634f * x)); }
struct EpiProj {
    static constexpr bool PERM = true, AFTER_DRAIN = false;
    bf16_t* CV; bf16_t* RT;
    __device__ __forceinline__ void operator()(const f32x4 (&acc)[2][2][4][2], const Unit& u, int wr, int wc, int fr, int fq) const {
        const int row0 = u.pm * BM + wr * 64;
        if (u.pn < 4) {
            bf16_t* base = CV + (size_t)(row0 + fr) * 1024 + u.pn * HALF + wc * 32 + 8 * fq;
#pragma unroll
            for (int ai = 0; ai < 2; ++ai)
#pragma unroll
                for (int m = 0; m < 4; ++m) __builtin_nontemporal_store(pack8(acc[ai][0][m][0] * acc[ai][1][m][0], acc[ai][0][m][1] * acc[ai][1][m][1]), (u32x4*)(base + (size_t)(ai * HALF + m * 16) * 1024));
            return;
        }
        const bool odd = fr & 1; const int re = row0 + (fr & ~1);
        bf16_t* base; size_t rstride; bool gate = false;
        if (u.pn < 6) { base = CV + (size_t)re * 1024 + 512 + (u.pn - 4) * BM + wc * 64 + (odd ? 32 : 0) + 8 * fq; rstride = 1024; }
        else { const int sec = u.pn - 6, which = sec >> 1, h = (sec & 1) * 2 + (wc >> 1), b = u.pm >> 3, s0 = re & 2047; gate = (which == 3);
               base = RT + ((size_t)(b * 4 + h) * 2048 + s0) * 512 + which * 128 + (wc & 1) * 64 + (odd ? 32 : 0) + 8 * fq; rstride = 512; }
#pragma unroll
        for (int ai = 0; ai < 2; ++ai)
#pragma unroll
            for (int m = 0; m < 4; ++m) { bf16_t* rowp = base + (size_t)(ai * HALF + m * 16) * rstride;
                f32x4 v[2][2];
#pragma unroll
                for (int bj = 0; bj < 2; ++bj)
#pragma unroll
                    for (int n = 0; n < 2; ++n) { v[bj][n] = acc[ai][bj][m][n];
                        if (gate) {
#pragma unroll
                            for (int j = 0; j < 4; ++j) v[bj][n][j] = silu_epi(v[bj][n][j]); } }
                u32x4 ev, od; pair_rows(pack8(v[0][0], v[0][1]), pack8(v[1][0], v[1][1]), odd, ev, od);
                __builtin_nontemporal_store(ev, (u32x4*)rowp); __builtin_nontemporal_store(od, (u32x4*)(rowp + rstride)); }
    }
};

template <class Epi, class Sched, bool ALIGN_EPI = false, bool SP2 = false>
__device__ __forceinline__ void gemm_phase(PG8_LAS unsigned char* lds, const Gemm g, const Sched& S, const Epi& E) {
    int tid_ = threadIdx.x; asm volatile("" : "+v"(tid_));
    const int tid = tid_, wid = __builtin_amdgcn_readfirstlane(tid >> 6), lane = tid & 63, wr = wid >> 2, wc = wid & 3, fr = lane & 15, fq = lane >> 4;
    const int K = g.K, nt = K / BK;
    unsigned voffA[2], voffB[2];
#pragma unroll
    for (int i = 0; i < 2; ++i) { int R, C; stage_rc(tid * 16 + i * 8192, R, C); const int Rb = Epi::PERM ? (64 * (R >> 5) + perm32(R & 31)) : R;
        voffA[i] = (unsigned)(R * K + C) * 2u; voffB[i] = (unsigned)(Rb * K + C) * 2u; }
    const size_t kstep = (size_t)(BK * 2);
    const size_t hstep = (size_t)HALF * K * 2;
    const size_t tstep = 2 * hstep;
    const size_t hstepB = Epi::PERM ? (size_t)32 * K * 2 : hstep;
    const unsigned ldsw = (unsigned)wid * 1024u;
    const int aoff = lds_byte(wr * 64 + fr, fq * 8), boff = lds_byte(wc * 32 + fr, fq * 8);
#define PG8_SA(b, h) (((b) * 2 + (h)) * HTB)
#define PG8_SB(b, h) ((4 + (b) * 2 + (h)) * HTB)
#define PG8_STAGE(bufoff, gbase, voff) do { _Pragma("unroll") for (int _i = 0; _i < 2; ++_i) \
        __builtin_amdgcn_global_load_lds((const unsigned*)((const char*)(gbase) + (voff)[_i]), (PG8_LAS unsigned*)(lds + (bufoff) + ldsw + _i * 8192), 16, 0, 0); } while (0)
#define PG8_LDA(dst, b, h) do { _Pragma("unroll") for (int m = 0; m < 4; ++m) _Pragma("unroll") for (int k = 0; k < 2; ++k) dst[m][k] = *(const PG8_LAS bf16x8*)(lds + PG8_SA(b, h) + aoff + m * 2048 + k * 1024); } while (0)
#define PG8_LDB(dst, b, h) do { _Pragma("unroll") for (int n = 0; n < 2; ++n) _Pragma("unroll") for (int k = 0; k < 2; ++k) dst[n][k] = *(const PG8_LAS bf16x8*)(lds + PG8_SB(b, h) + boff + n * 2048 + k * 1024); } while (0)
#define PG8_MMA(ai, bj, At, Bt) do { __builtin_amdgcn_s_setprio(1); _Pragma("unroll") for (int m = 0; m < 4; ++m) _Pragma("unroll") for (int n = 0; n < 2; ++n) _Pragma("unroll") for (int k = 0; k < 2; ++k) \
        acc[ai][bj][m][n] = __builtin_amdgcn_mfma_f32_16x16x32_bf16(Bt[n][k], At[m][k], acc[ai][bj][m][n], 0, 0, 0); __builtin_amdgcn_s_setprio(0); } while (0)
#define PG8_WAIT_V(n) asm volatile("s_waitcnt vmcnt(" #n ")" ::: "memory")
#define PG8_WAIT_L(n) asm volatile("s_waitcnt lgkmcnt(" #n ")" ::: "memory")
#define PG8_BAR __builtin_amdgcn_s_barrier()
#define PG8_SCHED __builtin_amdgcn_sched_barrier(0)
    Unit cur, nxt; int ui = 0;
    if (!S.next(0, cur)) return;
    f32x4 acc[2][2][4][2];
#pragma unroll
    for (int a = 0; a < 2; ++a)
#pragma unroll
        for (int b = 0; b < 2; ++b)
#pragma unroll
            for (int m = 0; m < 4; ++m)
#pragma unroll
                for (int n = 0; n < 2; ++n) acc[a][b][m][n] = (f32x4){0.f, 0.f, 0.f, 0.f};
    bf16x8 At[4][2], B0[2][2], B1[2][2];
    const char* cA = (const char*)g.A + (size_t)cur.pm * tstep; const char* cB = (const char*)g.Bt + (size_t)cur.pn * tstep;
    S.a_ready(cur);
    if constexpr (SP2) {
        PG8_STAGE(PG8_SB(0, 0), cB, voffB); PG8_STAGE(PG8_SB(0, 1), cB + hstepB, voffB); PG8_STAGE(PG8_SA(0, 0), cA, voffA); PG8_STAGE(PG8_SA(0, 1), cA + hstep, voffA);
        if (wr == 1) PG8_BAR;
        PG8_WAIT_V(2); PG8_BAR;
        PG8_STAGE(PG8_SB(1, 0), cB + kstep, voffB); PG8_STAGE(PG8_SA(1, 0), cA + kstep, voffA); PG8_STAGE(PG8_SB(1, 1), cB + hstepB + kstep, voffB);
        PG8_WAIT_V(6); PG8_BAR;
    } else {
        PG8_STAGE(PG8_SB(0, 0), cB, voffB); PG8_STAGE(PG8_SA(0, 0), cA, voffA); PG8_STAGE(PG8_SB(0, 1), cB + hstepB, voffB); PG8_STAGE(PG8_SA(0, 1), cA + hstep, voffA);
        if (wr == 1) PG8_BAR;
        PG8_WAIT_V(4); PG8_BAR;
        PG8_STAGE(PG8_SB(1, 0), cB + kstep, voffB); PG8_STAGE(PG8_SA(1, 0), cA + kstep, voffA); PG8_STAGE(PG8_SB(1, 1), cB + hstepB + kstep, voffB);
        PG8_WAIT_V(6); PG8_BAR;
    }
    for (;;) {
        const bool has_next = S.next(ui + 1, nxt);
        const char* nA = has_next ? (const char*)g.A + (size_t)nxt.pm * tstep : cA; const char* nB = has_next ? (const char*)g.Bt + (size_t)nxt.pn * tstep : cB;
        for (int t = 0; t < nt; t += 2) {
            const bool last = (t == nt - 2);
            const char* a1 = cA + (size_t)(t + 1) * kstep;
            const char* a2 = last ? nA : cA + (size_t)(t + 2) * kstep; const char* b2 = last ? nB : cB + (size_t)(t + 2) * kstep;
            const char* a3 = a2 + kstep; const char* b3 = b2 + kstep;
            if (last && has_next) S.a_ready(nxt);
            if constexpr (SP2) {
            PG8_LDB(B0, 0, 0); PG8_LDB(B1, 0, 1); PG8_SCHED; PG8_LDA(At, 0, 0); PG8_STAGE(PG8_SA(1, 1), a1 + hstep, voffA);
            PG8_WAIT_V(8); PG8_WAIT_L(0); PG8_BAR; PG8_MMA(0, 0, At, B0); PG8_MMA(0, 1, At, B1); PG8_BAR; PG8_SCHED;
            PG8_LDA(At, 0, 1); PG8_STAGE(PG8_SB(0, 0), b2, voffB); PG8_STAGE(PG8_SB(0, 1), b2 + hstepB, voffB); PG8_STAGE(PG8_SA(0, 0), a2, voffA);
            PG8_WAIT_V(8); PG8_WAIT_L(0); PG8_BAR; PG8_MMA(1, 0, At, B0); PG8_MMA(1, 1, At, B1); PG8_BAR; PG8_SCHED;
            PG8_LDB(B0, 1, 0); PG8_LDB(B1, 1, 1); PG8_SCHED; PG8_LDA(At, 1, 0); PG8_STAGE(PG8_SA(0, 1), a2 + hstep, voffA);
            PG8_WAIT_V(8); PG8_WAIT_L(0); PG8_BAR; PG8_MMA(0, 0, At, B0); PG8_MMA(0, 1, At, B1); PG8_BAR; PG8_SCHED;
            PG8_LDA(At, 1, 1); PG8_STAGE(PG8_SB(1, 0), b3, voffB); PG8_STAGE(PG8_SB(1, 1), b3 + hstepB, voffB); PG8_STAGE(PG8_SA(1, 0), a3, voffA);
            PG8_WAIT_V(8); PG8_WAIT_L(0); PG8_BAR; PG8_MMA(1, 0, At, B0); PG8_MMA(1, 1, At, B1); PG8_BAR; PG8_SCHED;
            } else {
            PG8_LDB(B0, 0, 0); PG8_SCHED; PG8_LDA(At, 0, 0); PG8_STAGE(PG8_SA(1, 1), a1 + hstep, voffA);
            PG8_WAIT_L(8); PG8_BAR; PG8_WAIT_L(0); PG8_MMA(0, 0, At, B0); PG8_BAR; PG8_SCHED;
            PG8_LDB(B1, 0, 1); PG8_STAGE(PG8_SB(0, 0), b2, voffB);
            PG8_BAR; PG8_WAIT_L(0); PG8_MMA(0, 1, At, B1); PG8_BAR;
            PG8_LDA(At, 0, 1); PG8_STAGE(PG8_SA(0, 0), a2, voffA);
            PG8_BAR; PG8_WAIT_L(0); PG8_MMA(1, 0, At, B0); PG8_BAR; PG8_SCHED;
            PG8_STAGE(PG8_SB(0, 1), b2 + hstepB, voffB);
            PG8_WAIT_V(6); PG8_BAR; PG8_MMA(1, 1, At, B1); PG8_BAR;
            PG8_LDB(B0, 1, 0); PG8_SCHED; PG8_LDA(At, 1, 0); PG8_STAGE(PG8_SA(0, 1), a2 + hstep, voffA);
            PG8_WAIT_L(8); PG8_BAR; PG8_WAIT_L(0); PG8_MMA(0, 0, At, B0); PG8_BAR; PG8_SCHED;
            PG8_LDB(B1, 1, 1); PG8_STAGE(PG8_SB(1, 0), b3, voffB);
            PG8_BAR; PG8_WAIT_L(0); PG8_MMA(0, 1, At, B1); PG8_BAR;
            PG8_LDA(At, 1, 1); PG8_STAGE(PG8_SA(1, 0), a3, voffA);
            PG8_BAR; PG8_WAIT_L(0); PG8_MMA(1, 0, At, B0); PG8_BAR; PG8_SCHED;
            PG8_STAGE(PG8_SB(1, 1), b3 + hstepB, voffB);
            PG8_WAIT_V(6); PG8_BAR; PG8_MMA(1, 1, At, B1); PG8_BAR;
            }
        }
        if constexpr (ALIGN_EPI) { if (wr == 0) PG8_BAR; }
        if constexpr (!Epi::AFTER_DRAIN) { E(acc, cur, wr, wc, fr, fq); S.done(cur); }
        if (!has_next) break;
#pragma unroll
        for (int a = 0; a < 2; ++a)
#pragma unroll
            for (int b = 0; b < 2; ++b)
#pragma unroll
                for (int m = 0; m < 4; ++m)
#pragma unroll
                    for (int n = 0; n < 2; ++n) acc[a][b][m][n] = (f32x4){0.f, 0.f, 0.f, 0.f};
        cur = nxt; cA = nA; cB = nB; ++ui;
        if constexpr (ALIGN_EPI) { if (wr == 1) PG8_BAR; }
    }
    PG8_WAIT_V(0);
    if constexpr (!ALIGN_EPI) { if (wr == 0) PG8_BAR; }
    PG8_BAR;
    if constexpr (Epi::AFTER_DRAIN) { E.fused(acc, cur, wr, wc, fr, fq, lds, wid, lane); S.done(cur); }
#undef PG8_SA
#undef PG8_SB
#undef PG8_STAGE
#undef PG8_LDA
#undef PG8_LDB
#undef PG8_MMA
#undef PG8_WAIT_V
#undef PG8_WAIT_L
#undef PG8_BAR
#undef PG8_SCHED
}
}

typedef short s16x4 __attribute__((ext_vector_type(4)));
__device__ __forceinline__ unsigned off_q(unsigned row, unsigned ch) { return 256u * row + 16u * (ch ^ (row & 15u)); }
__device__ __forceinline__ unsigned off_b(unsigned row, unsigned ch) { return 256u * row + 16u * (ch ^ (((row & 3u) << 2) | ((row >> 2) & 3u))); }
__device__ __forceinline__ bf16x8 tr_frag(LAS unsigned char* base, unsigned a0, unsigned a1) {
    const s16x4 x = __builtin_amdgcn_ds_read_tr16_b64_v4i16((LAS s16x4*)(base + a0));
    const s16x4 y = __builtin_amdgcn_ds_read_tr16_b64_v4i16((LAS s16x4*)(base + a1));
    return __builtin_shufflevector(x, y, 0, 1, 2, 3, 4, 5, 6, 7);
}
constexpr unsigned RT_QKV = 49152, RT_ST = 98304, RT_ST_STR = 272, RT_PS = RT_ST + 128 * RT_ST_STR, RT_PS_STR = 144, RT_RED = RT_PS + 64 * RT_PS_STR, RT_END = RT_RED + 1024;
struct RetLoads { v4u q1, q2, k1, k2, v1, v2; int pos; };
template <bool WQ> __device__ __forceinline__ void ret_issue_loads(RetLoads& R, const bf16* gq, const int* ppos) {
    if (WQ) { R.q1 = __builtin_nontemporal_load((const GAS v4u*)(gq)); R.q2 = __builtin_nontemporal_load((const GAS v4u*)(gq + 64)); }
    R.k1 = __builtin_nontemporal_load((const GAS v4u*)(gq + 128)); R.k2 = __builtin_nontemporal_load((const GAS v4u*)(gq + 128 + 64));
    R.v1 = __builtin_nontemporal_load((const GAS v4u*)(gq + 256)); R.v2 = __builtin_nontemporal_load((const GAS v4u*)(gq + 256 + 64));
    R.pos = *ppos;
}
template <bool WQ> __device__ __forceinline__ void ret_stage_write(const RetLoads& R, LAS unsigned char* Qb, int srow, int sch, const float (&invf)[8], float vdec) {
    const unsigned k1w[4] = {R.k1.x, R.k1.y, R.k1.z, R.k1.w}, k2w[4] = {R.k2.x, R.k2.y, R.k2.z, R.k2.w};
    const unsigned v1w[4] = {R.v1.x, R.v1.y, R.v1.z, R.v1.w}, v2w[4] = {R.v2.x, R.v2.y, R.v2.z, R.v2.w};
    unsigned oq1[4], oq2[4], ok1[4], ok2[4], ov1[4], ov2[4];
    constexpr float KSC = 0.08838834764831845f;
#pragma unroll
    for (int i = 0; i < 4; ++i) {
        float c0, s0, c1, s1; rope_cs(R.pos, invf[2 * i], c0, s0); rope_cs(R.pos, invf[2 * i + 1], c1, s1);
        if (WQ) { const unsigned q1w[4] = {R.q1.x, R.q1.y, R.q1.z, R.q1.w}, q2w[4] = {R.q2.x, R.q2.y, R.q2.z, R.q2.w};
            const float qa0 = bflo(q1w[i]), qa1 = bfhi(q1w[i]), qb0 = bflo(q2w[i]), qb1 = bfhi(q2w[i]);
            oq1[i] = pk2(qa0 * c0 - qb0 * s0, qa1 * c1 - qb1 * s1); oq2[i] = pk2(qb0 * c0 + qa0 * s0, qb1 * c1 + qa1 * s1); }
        const float ka0 = bflo(k1w[i]), ka1 = bfhi(k1w[i]), kb0 = bflo(k2w[i]), kb1 = bfhi(k2w[i]);
        ok1[i] = pk2((ka0 * c0 - kb0 * s0) * KSC, (ka1 * c1 - kb1 * s1) * KSC); ok2[i] = pk2((kb0 * c0 + ka0 * s0) * KSC, (kb1 * c1 + ka1 * s1) * KSC);
        ov1[i] = pk2(bflo(v1w[i]) * vdec, bfhi(v1w[i]) * vdec); ov2[i] = pk2(bflo(v2w[i]) * vdec, bfhi(v2w[i]) * vdec);
    }
    const unsigned o1 = off_b(srow, sch), o2 = off_b(srow, sch + 8);
    if (WQ) { *(LAS v4u*)(Qb + off_q(srow, sch)) = (v4u){oq1[0], oq1[1], oq1[2], oq1[3]}; *(LAS v4u*)(Qb + off_q(srow, sch + 8)) = (v4u){oq2[0], oq2[1], oq2[2], oq2[3]}; }
    *(LAS v4u*)(Qb + 16384 + o1) = (v4u){ok1[0], ok1[1], ok1[2], ok1[3]}; *(LAS v4u*)(Qb + 16384 + o2) = (v4u){ok2[0], ok2[1], ok2[2], ok2[3]};
    *(LAS v4u*)(Qb + 32768 + o1) = (v4u){ov1[0], ov1[1], ov1[2], ov1[3]}; *(LAS v4u*)(Qb + 32768 + o2) = (v4u){ov2[0], ov2[1], ov2[2], ov2[3]};
}
__device__ __forceinline__ void ret_unit(const Frame& F, int unit, int n0, int n1) {
    LAS unsigned char* L = F.lds;
    int t_ = threadIdx.x; asm volatile("" : "+v"(t_));
    const int t = t_, l = t & 63, w = __builtin_amdgcn_readfirstlane(t >> 6), g = l >> 4, fr = l & 15, q4 = fr >> 2, p4 = l & 3, cw = w >> 2, ew = w & 3;
    const int b = unit >> 2, h = unit & 3;
    const float lg = log1pf(-exp2f(-5.0f - (float)h));
    float maskp[2][4], qd[2];
#pragma unroll
    for (int ct = 0; ct < 2; ++ct) { const int c = 16 * (2 * cw + ct) + fr; qd[ct] = expf(lg * (float)(c + 1));
#pragma unroll
        for (int r = 0; r < 4; ++r) { const int m = 16 * ew + 4 * g + r; const int ad = c > m ? c - m : m - c; maskp[ct][r] = expf(lg * (float)(ad - 63 + m)); } }
    const float cdec = expf(lg * 64.0f);
    const int srow = t >> 3, sch = t & 7;
    const float vdec = expf(lg * (float)(63 - srow));
    float invf[8];
    { const f32x4 fa = *(const f32x4*)(F.invf_tab + sch * 8), fb = *(const f32x4*)(F.invf_tab + sch * 8 + 4);
      invf[0] = fa[0]; invf[1] = fa[1]; invf[2] = fa[2]; invf[3] = fa[3]; invf[4] = fb[0]; invf[5] = fb[1]; invf[6] = fb[2]; invf[7] = fb[3]; }
    const size_t row0 = (size_t)b * SEQ;
    const bf16* rt = F.RETB + (size_t)unit * SEQ * 512;
    const bf16* gq = rt + (size_t)srow * 512 + sch * 8;
    const int* ppos = F.positions + row0 + srow;
    f32x4 acc4[4][2];
#pragma unroll
    for (int dt = 0; dt < 4; ++dt)
#pragma unroll
        for (int et = 0; et < 2; ++et) acc4[dt][et] = (f32x4){0.f, 0.f, 0.f, 0.f};
    __syncthreads();
    if (n0 > 0) {
        { RetLoads R; ret_issue_loads<false>(R, gq, ppos); ret_stage_write<false>(R, L, srow, sch, invf, vdec); }
        __syncthreads();
        RetLoads PA, PB;
        if (1 < n0) ret_issue_loads<false>(PA, gq + (size_t)CH * 512, ppos + CH);
#define RET_PRE(n, PST, PLD) { \
            LAS unsigned char* Kb = L + ((n) & 1) * RT_QKV + 16384; LAS unsigned char* Vb = Kb + 16384; \
            if ((n) + 2 < n0) ret_issue_loads<false>(PLD, gq + (size_t)((n) + 2) * CH * 512, ppos + ((n) + 2) * CH); \
            _Pragma("unroll") for (int dt = 0; dt < 4; ++dt) _Pragma("unroll") for (int et = 0; et < 2; ++et) acc4[dt][et] = acc4[dt][et] * cdec; \
            _Pragma("unroll") for (int s = 0; s < 2; ++s) { \
                bf16x8 vfp[2]; \
                _Pragma("unroll") for (int et = 0; et < 2; ++et) { const unsigned ch = 2 * (2 * ew + et) + (p4 >> 1), r0 = 32 * s + 8 * g + q4; \
                    vfp[et] = tr_frag(Vb, off_b(r0, ch) + 8 * (p4 & 1), off_b(r0 + 4, ch) + 8 * (p4 & 1)); } \
                _Pragma("unroll") for (int dt = 0; dt < 4; ++dt) { const unsigned ch = 2 * (4 * cw + dt) + (p4 >> 1), r0 = 32 * s + 8 * g + q4; \
                    const bf16x8 kt = tr_frag(Kb, off_b(r0, ch) + 8 * (p4 & 1), off_b(r0 + 4, ch) + 8 * (p4 & 1)); \
                    _Pragma("unroll") for (int et = 0; et < 2; ++et) acc4[dt][et] = __builtin_amdgcn_mfma_f32_16x16x32_bf16(kt, vfp[et], acc4[dt][et], 0, 0, 0); } \
            } \
            if ((n) + 1 < n0) ret_stage_write<false>(PST, L + (((n) + 1) & 1) * RT_QKV, srow, sch, invf, vdec); \
            __syncthreads(); }
        for (int n = 0; n < n0; n += 2) { RET_PRE(n, PA, PB) { const int n_odd = n + 1; RET_PRE(n_odd, PB, PA) } }
#undef RET_PRE
#pragma unroll
        for (int dt = 0; dt < 4; ++dt)
#pragma unroll
            for (int et = 0; et < 2; ++et) { v2u sw; sw.x = pk2(acc4[dt][et][0], acc4[dt][et][1]); sw.y = pk2(acc4[dt][et][2], acc4[dt][et][3]);
                *(LAS v2u*)(L + RT_ST + (16 * (2 * ew + et) + fr) * RT_ST_STR + (16 * (4 * cw + dt) + 4 * g) * 2) = sw; }
    } else {
        for (int i = t; i < (128 * (int)RT_ST_STR) / 4; i += 512) ((LAS unsigned*)(L + RT_ST))[i] = 0u;
    }
    { RetLoads R; ret_issue_loads<true>(R, gq + (size_t)n0 * CH * 512, ppos + n0 * CH); ret_stage_write<true>(R, L + (n0 & 1) * RT_QKV, srow, sch, invf, vdec); }
    __syncthreads();
    v2u gv[2][2];
#pragma unroll
    for (int ct = 0; ct < 2; ++ct)
#pragma unroll
        for (int et = 0; et < 2; ++et) gv[ct][et] = *(const GAS v2u*)(rt + ((size_t)n0 * CH + 16 * (2 * cw + ct) + fr) * 512 + 384 + 16 * (2 * ew + et) + 4 * g);
    for (int n = n0; n < n1; ++n) {
        LAS unsigned char* Qb = L + (n & 1) * RT_QKV; LAS unsigned char* Kb = Qb + 16384; LAS unsigned char* Vb = Qb + 32768;
        const bool has_next = (n + 1 < n1);
        RetLoads R;
        if (has_next) ret_issue_loads<true>(R, gq + (size_t)(n + 1) * CH * 512, ppos + (n + 1) * CH);
        v2u gvn[2][2];
        if (has_next) {
#pragma unroll
            for (int ct = 0; ct < 2; ++ct)
#pragma unroll
                for (int et = 0; et < 2; ++et)
                    gvn[ct][et] = *(const GAS v2u*)(rt + ((size_t)(n + 1) * CH + 16 * (2 * cw + ct) + fr) * 512 + 384 + 16 * (2 * ew + et) + 4 * g);
        }
        bf16x8 qf[2][4];
#pragma unroll
        for (int ct = 0; ct < 2; ++ct)
#pragma unroll
            for (int s = 0; s < 4; ++s) qf[ct][s] = *(const LAS bf16x8*)(Qb + off_q(16 * (2 * cw + ct) + fr, 4 * s + g));
        f32x4 a1[2] = {(f32x4){0.f, 0.f, 0.f, 0.f}, (f32x4){0.f, 0.f, 0.f, 0.f}};
#pragma unroll
        for (int s = 0; s < 4; ++s) { const bf16x8 kf = *(const LAS bf16x8*)(Kb + off_b(16 * ew + fr, 4 * s + g));
#pragma unroll
            for (int ct = 0; ct < 2; ++ct) a1[ct] = __builtin_amdgcn_mfma_f32_16x16x32_bf16(kf, qf[ct][s], a1[ct], 0, 0, 0); }
#pragma unroll
        for (int ct = 0; ct < 2; ++ct) { v2u pw; pw.x = pk2(a1[ct][0] * maskp[ct][0], a1[ct][1] * maskp[ct][1]); pw.y = pk2(a1[ct][2] * maskp[ct][2], a1[ct][3] * maskp[ct][3]);
            *(LAS v2u*)(L + RT_PS + (16 * (2 * cw + ct) + fr) * RT_PS_STR + (16 * ew + 4 * g) * 2) = pw; }
        f32x4 aX[2][2], aI[2][2];
#pragma unroll
        for (int ct = 0; ct < 2; ++ct)
#pragma unroll
            for (int et = 0; et < 2; ++et) { aX[ct][et] = (f32x4){0.f, 0.f, 0.f, 0.f}; aI[ct][et] = (f32x4){0.f, 0.f, 0.f, 0.f}; }
#pragma unroll
        for (int s = 0; s < 4; ++s)
#pragma unroll
            for (int et = 0; et < 2; ++et) { const bf16x8 sf = *(const LAS bf16x8*)(L + RT_ST + (16 * (2 * ew + et) + fr) * RT_ST_STR + (32 * s + 8 * g) * 2);
#pragma unroll
                for (int ct = 0; ct < 2; ++ct) aX[ct][et] = __builtin_amdgcn_mfma_f32_16x16x32_bf16(sf, qf[ct][s], aX[ct][et], 0, 0, 0); }
        __syncthreads();
        bf16x8 vf[2][2];
#pragma unroll
        for (int et = 0; et < 2; ++et)
#pragma unroll
            for (int s = 0; s < 2; ++s) { const unsigned ch = 2 * (2 * ew + et) + (p4 >> 1), r0 = 32 * s + 8 * g + q4;
                vf[et][s] = tr_frag(Vb, off_b(r0, ch) + 8 * (p4 & 1), off_b(r0 + 4, ch) + 8 * (p4 & 1)); }
#pragma unroll
        for (int s = 0; s < 2; ++s)
#pragma unroll
            for (int ct = 0; ct < 2; ++ct) { const bf16x8 pf = *(const LAS bf16x8*)(L + RT_PS + (16 * (2 * cw + ct) + fr) * RT_PS_STR + (32 * s + 8 * g) * 2);
#pragma unroll
                for (int et = 0; et < 2; ++et) aI[ct][et] = __builtin_amdgcn_mfma_f32_16x16x32_bf16(vf[et][s], pf, aI[ct][et], 0, 0, 0); }
#pragma unroll
        for (int dt = 0; dt < 4; ++dt)
#pragma unroll
            for (int et = 0; et < 2; ++et) acc4[dt][et] = acc4[dt][et] * cdec;
#pragma unroll
        for (int s = 0; s < 2; ++s)
#pragma unroll
            for (int dt = 0; dt < 4; ++dt) { const unsigned ch = 2 * (4 * cw + dt) + (p4 >> 1), r0 = 32 * s + 8 * g + q4;
                const bf16x8 kt = tr_frag(Kb, off_b(r0, ch) + 8 * (p4 & 1), off_b(r0 + 4, ch) + 8 * (p4 & 1));
#pragma unroll
                for (int et = 0; et < 2; ++et) acc4[dt][et] = __builtin_amdgcn_mfma_f32_16x16x32_bf16(kt, vf[et][s], acc4[dt][et], 0, 0, 0); }
#pragma unroll
        for (int dt = 0; dt < 4; ++dt)
#pragma unroll
            for (int et = 0; et < 2; ++et) { v2u sw; sw.x = pk2(acc4[dt][et][0], acc4[dt][et][1]); sw.y = pk2(acc4[dt][et][2], acc4[dt][et][3]);
                *(LAS v2u*)(L + RT_ST + (16 * (2 * ew + et) + fr) * RT_ST_STR + (16 * (4 * cw + dt) + 4 * g) * 2) = sw; }
#pragma unroll
        for (int ct = 0; ct < 2; ++ct) { float ss = 0.f;
#pragma unroll
            for (int et = 0; et < 2; ++et) { aI[ct][et] = aI[ct][et] + aX[ct][et] * qd[ct];
                ss += (aI[ct][et][0] * aI[ct][et][0] + aI[ct][et][1] * aI[ct][et][1]) + (aI[ct][et][2] * aI[ct][et][2] + aI[ct][et][3] * aI[ct][et][3]); }
            ss += __shfl_xor(ss, 16); ss += __shfl_xor(ss, 32);
            if (g == 0) ((LAS float*)(L + RT_RED))[(16 * (2 * cw + ct) + fr) * 4 + ew] = ss; }
        if (has_next) ret_stage_write<true>(R, L + ((n + 1) & 1) * RT_QKV, srow, sch, invf, vdec);
        __syncthreads();
#pragma unroll
        for (int ct = 0; ct < 2; ++ct) { const int c = 16 * (2 * cw + ct) + fr; const f32x4 rs = *(const LAS f32x4*)(L + RT_RED + c * 16);
            const float rstd = 1.0f / sqrtf(((rs.x + rs.y) + (rs.z + rs.w)) * (1.f / 128.f) + EPS);
#pragma unroll
            for (int et = 0; et < 2; ++et) { const v2u gg = gv[ct][et];
                v2u o; o.x = pk2(bflo(gg.x) * aI[ct][et][0] * rstd, bfhi(gg.x) * aI[ct][et][1] * rstd);
                o.y = pk2(bflo(gg.y) * aI[ct][et][2] * rstd, bfhi(gg.y) * aI[ct][et][3] * rstd);
                *(GAS v2u*)(F.MIXIN + (row0 + (size_t)n * CH + c) * D + CONV + h * DH + 16 * (2 * ew + et) + 4 * g) = o; } }
        if (has_next) {
#pragma unroll
            for (int ct = 0; ct < 2; ++ct)
#pragma unroll
                for (int et = 0; et < 2; ++et) gv[ct][et] = gvn[ct][et];
        }
    }
}

#define XB_TMO      128
#define XB_XCNT(j)  (256  + 64 * (j))
#define XB_XSUB(j)  (1280 + 64 * (j))
#define XB_XGEN(j)  (2304 + 64 * (j))
#define XB_TOP      3328
#define XB_TOPGEN   3392
#define XCD_BAR_WORDS 3456
#define XB_SPIN_CAP (1u << 18)

__device__ __forceinline__ unsigned xb_ld(unsigned* p)              { return __hip_atomic_load(p, __ATOMIC_RELAXED, __HIP_MEMORY_SCOPE_AGENT); }
__device__ __forceinline__ unsigned xb_add(unsigned* p, unsigned v) { return __hip_atomic_fetch_add(p, v, __ATOMIC_RELAXED, __HIP_MEMORY_SCOPE_AGENT); }
__device__ __forceinline__ unsigned xb_xcc_id() { return (unsigned)__builtin_amdgcn_s_getreg((3 << 11) | 20) & 0xFu; }
#define XB_SPIN(cond, bar) do { unsigned _sp = 0; while (cond) { __builtin_amdgcn_s_sleep(1); \
    if ((++_sp & 255u) == 0u) { if (xb_ld(&(bar)[XB_TMO])) break; if (_sp > XB_SPIN_CAP) { atomicAdd(&(bar)[XB_TMO], 1u); break; } } } } while (0)

struct XcdBarrier {
    unsigned* bar; unsigned x;
    volatile LAS unsigned* st;
};

__device__ __forceinline__ XcdBarrier xcd_barrier_post(unsigned* bar, volatile LAS unsigned* st) {
    XcdBarrier b; b.bar = bar; b.x = xb_xcc_id(); b.st = st;
    if (threadIdx.x == 0) (void)xb_add(&bar[XB_XCNT(b.x)], 1u);
    return b;
}
__device__ __forceinline__ void xcd_barrier_complete(unsigned* bar, unsigned x, unsigned& nloc, unsigned& nx) {
    const unsigned G = gridDim.x * gridDim.y * gridDim.z;
    unsigned sum, cnt, mine, sp = 0u;
    for (;;) {
        sum = 0u; cnt = 0u; mine = 0u;
#pragma unroll
        for (unsigned j = 0; j < 16; ++j) { const unsigned c = xb_ld(&bar[XB_XCNT(j)]); sum += c; cnt += (c > 0u) ? 1u : 0u; mine = (j == x) ? c : mine; }
        if (sum == G) break;
        __builtin_amdgcn_s_sleep(1);
        if ((++sp & 255u) == 0u) { if (xb_ld(&bar[XB_TMO])) break; if (sp > XB_SPIN_CAP) { atomicAdd(&bar[XB_TMO], 1u); break; } }
    }
    nloc = mine > 0u ? mine : 1u; nx = cnt > 0u ? cnt : 1u;
}

__device__ __forceinline__ void xcd_barrier(const XcdBarrier& b) {
    asm volatile("s_waitcnt vmcnt(0)" ::: "memory");
    __syncthreads();
    if (threadIdx.x == 0) {
        unsigned* bar = b.bar;
        __builtin_amdgcn_s_waitcnt(0);
        unsigned nloc = b.st[0], nx = b.st[1];
        if (nloc == 0u) { xcd_barrier_complete(bar, b.x, nloc, nx); b.st[0] = nloc; b.st[1] = nx; }
        const unsigned old = xb_add(&bar[XB_XSUB(b.x)], 1u);
        const unsigned gen = old / nloc;
        if (old + 1u == (gen + 1u) * nloc) {
            __builtin_amdgcn_fence(__ATOMIC_RELEASE, "agent");
            asm volatile("s_waitcnt vmcnt(0)" ::: "memory");
            const unsigned og = xb_add(&bar[XB_TOP], 1u);
            const unsigned tg = og / nx;
            if (og + 1u == (tg + 1u) * nx) xb_add(&bar[XB_TOPGEN], 1u);
            else XB_SPIN(xb_ld(&bar[XB_TOPGEN]) == tg, bar);
            __builtin_amdgcn_fence(__ATOMIC_ACQUIRE, "agent");
            xb_add(&bar[XB_XGEN(b.x)], 1u);
            asm volatile("s_waitcnt vmcnt(0)" ::: "memory");
        } else {
            XB_SPIN(xb_ld(&bar[XB_XGEN(b.x)]) == gen, bar);
            __builtin_amdgcn_fence(__ATOMIC_ACQUIRE, "agent");
            asm volatile("s_waitcnt vmcnt(0)" ::: "memory");
        }
    }
    __syncthreads();
}

constexpr int LDS_BYTES = 147456;
constexpr int LDS_CTL_OFF = 147456 - 64;
struct Args { const void* in[14]; float* out; unsigned char* ws; };
__device__ __forceinline__ Frame make_frame(const Args& a, LAS unsigned char* lds) {
    Frame F; F.lds = lds; F.tid = threadIdx.x; F.lane = F.tid & 63; F.wave = __builtin_amdgcn_readfirstlane(F.tid >> 6);
    F.G = gridDim.x; { const int bx = blockIdx.x; F.vcu = (F.G % 8 == 0) ? (bx % 8) * (F.G / 8) + bx / 8 : bx; }
    F.x = (const float*)a.in[0]; F.c = (const float*)a.in[1]; F.positions = (const int*)a.in[2]; F.w_ada = (const float*)a.in[3]; F.b_ada = (const float*)a.in[4];
    F.g_pre_mix = (const float*)a.in[5]; F.g_post_mix = (const float*)a.in[6]; F.w_in = (const float*)a.in[7]; F.conv_w = (const float*)a.in[8]; F.w_out = (const float*)a.in[9];
    F.g_pre_mlp = (const float*)a.in[10]; F.g_post_mlp = (const float*)a.in[11]; F.w_fc1 = (const float*)a.in[12]; F.w_fc2 = (const float*)a.in[13];
    F.out = a.out; unsigned char* ws = a.ws;
    F.modp = (float*)(ws + WS_MODP); F.mod = (float*)(ws + WS_MOD); F.invf_tab = (float*)(ws + WS_MOD + 1 * MiB);
    F.Win_t = (bf16*)(ws + WS_WIN); F.Wout_t = (bf16*)(ws + WS_WOUT); F.W1_t = (bf16*)(ws + WS_W1); F.W2_t = (bf16*)(ws + WS_W2);
    F.H = (bf16*)(ws + WS_H); F.BIG = (bf16*)(ws + WS_BIG); F.MIXIN = (bf16*)(ws + WS_MIXIN); F.MIX = (bf16*)(ws + WS_MIX);
    F.CONVB = F.BIG; F.RETB = F.BIG + (size_t)M * 1024;
    return F;
}
__global__ void __launch_bounds__(512, 2) mk_fwd(Args a) {
    extern __shared__ __attribute__((aligned(16))) unsigned char lds[];
    cg::grid_group grid = cg::this_grid();
    Frame F = make_frame(a, (LAS unsigned char*)lds);
    volatile LAS unsigned* bst = (volatile LAS unsigned*)(F.lds + LDS_CTL_OFF);
    if (F.tid < 4) bst[F.tid] = 0u;
    __syncthreads();
    const XcdBarrier xb = xcd_barrier_post((unsigned*)(a.ws + WS_CTL), bst);
    p0_prologue(F);
    grid.sync();
    p1_h1(F);
    xcd_barrier(xb);
    { pg8::Gemm g{F.H, F.Win_t, M, IN_DIM, D}; pg8::StaticOrder S; S.init(M, IN_DIM, F.G, (int)blockIdx.x); pg8::EpiProj E{F.CONVB, F.RETB};
      pg8::gemm_phase<pg8::EpiProj, pg8::StaticOrder, false, true>(F.lds, g, S, E); }
    xcd_barrier(xb);
    { const int bx = blockIdx.x, NU = BATCH * HEADS;
      for (int u = bx; u < 2 * NU; u += F.G) { const int half = u & 1; ret_unit(F, u >> 1, half ? NCHUNK / 2 : 0, half ? NCHUNK : NCHUNK / 2); }
      unsigned* cctr = (unsigned*)(a.ws + WS_CTL) + 3520;
      for (;;) {
          __syncthreads();
          if (F.tid == 0) bst[4] = xb_add(cctr, 1u);
          __syncthreads();
          const unsigned ci = bst[4];
          if (ci >= (unsigned)(M / 128)) break;
          conv_seg16(F, (int)ci * 8 + F.wave, F.lane);
      } }
    xcd_barrier(xb);
    { pg8::Gemm g{F.MIXIN, F.Wout_t, M, D, D}; pg8::StaticOrder S; S.init(M, D, F.G, (int)blockIdx.x); pg8::EpiBf16<0> E{F.MIX, D};
      pg8::gemm_phase<pg8::EpiBf16<0>, pg8::StaticOrder, false, true>(F.lds, g, S, E); }
    xcd_barrier(xb);
    p5_postmix(F);
    xcd_barrier(xb);
    { pg8::Gemm g{F.H, F.W1_t, M, FF, D}; pg8::StaticOrder S; S.init(M, FF, F.G, (int)blockIdx.x); pg8::EpiBf16<2> E{F.BIG, FF};
      pg8::gemm_phase<pg8::EpiBf16<2>, pg8::StaticOrder, false, true>(F.lds, g, S, E); }
    xcd_barrier(xb);
    { pg8::Gemm g{F.BIG, F.W2_t, M, D, FF}; pg8::StaticOrder S; S.init(M, D, F.G, (int)blockIdx.x); pg8::EpiBf16<0> E{F.MIXIN, D};
      pg8::gemm_phase<pg8::EpiBf16<0>, pg8::StaticOrder, false, true>(F.lds, g, S, E); }
    xcd_barrier(xb);
    p8_final(F);
}

extern "C" void kernel_launch(void* const* d_in, const int* in_sizes, int n_in, void* d_out, int out_size, void* d_ws, size_t ws_size, hipStream_t stream) {
    static int grid = 0;
    if (grid == 0) {
        if (n_in != 14 || in_sizes[0] != M * D || out_size != M * D || ws_size < WS_END) { fprintf(stderr, "kernel_launch: unexpected shapes (n_in %d in0 %d out %d ws %zu)\n", n_in, n_in > 0 ? in_sizes[0] : -1, out_size, ws_size); grid = -1; return; }
        if (hipFuncSetAttribute((const void*)mk_fwd, hipFuncAttributeMaxDynamicSharedMemorySize, LDS_BYTES) != hipSuccess) { fprintf(stderr, "kernel_launch: hipFuncSetAttribute failed\n"); grid = -1; return; }
        int dev = 0, cus = 0, per_cu = 0;
        if (hipGetDevice(&dev) != hipSuccess || hipDeviceGetAttribute(&cus, hipDeviceAttributeMultiprocessorCount, dev) != hipSuccess) { fprintf(stderr, "kernel_launch: device query failed\n"); grid = -1; return; }
        if (hipOccupancyMaxActiveBlocksPerMultiprocessor(&per_cu, (const void*)mk_fwd, 512, LDS_BYTES) != hipSuccess || per_cu < 1) { fprintf(stderr, "kernel_launch: occupancy query failed (%d)\n", per_cu); grid = -1; return; }
        grid = cus;
        fprintf(stderr, "kernel_launch: %d CUs, occupancy %d per CU, grid %d\n", cus, per_cu, grid);
    }
    if (grid < 0) return;
    Args a{};
    for (int i = 0; i < 14; ++i) a.in[i] = d_in[i];
    a.out = (float*)d_out; a.ws = (unsigned char*)d_ws;
    if (hipMemsetAsync((char*)d_ws + WS_CTL, 0, 16384, stream) != hipSuccess) { fprintf(stderr, "kernel_launch: memset failed\n"); return; }
    void* args[] = {&a};
    hipError_t e = hipLaunchCooperativeKernel((const void*)mk_fwd, dim3(grid), dim3(512), args, LDS_BYTES, stream);
    if (e != hipSuccess) fprintf(stderr, "kernel_launch: cooperative launch failed: %s (grid %d)\n", hipGetErrorString(e), grid);
}
```

```cpp
#include <hip/hip_runtime.h>
#include <hip/hip_cooperative_groups.h>
namespace cg = cooperative_groups;
#include <cstdio>
#include <cstdint>

#define GAS __attribute__((address_space(1)))
#define LAS __attribute__((address_space(3)))
typedef unsigned short bf16;
typedef unsigned v4u __attribute__((ext_vector_type(4)));
typedef unsigned v2u __attribute__((ext_vector_type(2)));
typedef float f32x4 __attribute__((ext_vector_type(4)));
typedef short bf16x8 __attribute__((ext_vector_type(8)));

constexpr int BATCH = 32, SEQ = 2048, D = 1024, M = BATCH * SEQ, CONV = 512, RET = 512, HEADS = 4, DH = 128, CH = 64;
constexpr int IN_DIM = 3584, FF = 4096, NMOD = 6144, NCHUNK = SEQ / CH;
constexpr int OFF_XIN = 0, OFF_B = 512, OFF_C = 1024, OFF_Q = 1536, OFF_K = 2048, OFF_V = 2560, OFF_G = 3072;
constexpr float EPS = 1e-6f;
constexpr int LDS_CTL_OFF_ = 147456 - 64;
constexpr int KS_MOD = 8;

constexpr size_t MiB = 1u << 20;
constexpr size_t WS_CTL = 0;
constexpr size_t WS_MODP = 2 * MiB;
constexpr size_t WS_MOD = 10 * MiB;
constexpr size_t WS_WIN = 12 * MiB;
constexpr size_t WS_WOUT = 20 * MiB;
constexpr size_t WS_W1 = 22 * MiB;
constexpr size_t WS_W2 = 30 * MiB;
constexpr size_t WS_H = 64 * MiB;
constexpr size_t WS_BIG = 192 * MiB;
constexpr size_t WS_MIXIN = 704 * MiB;
constexpr size_t WS_MIX = 832 * MiB;
constexpr size_t WS_END = 960 * MiB;

__device__ __forceinline__ unsigned f2bf(float f) { unsigned u = __builtin_bit_cast(unsigned, f); return (u + 0x7fffu + ((u >> 16) & 1u)) >> 16; }
typedef __bf16 bfv2 __attribute__((ext_vector_type(2)));
typedef float f32x2 __attribute__((ext_vector_type(2)));
__device__ __forceinline__ unsigned pk2(float lo, float hi) { return __builtin_bit_cast(unsigned, __builtin_convertvector((f32x2){lo, hi}, bfv2)); }
__device__ __forceinline__ float bf2f(unsigned short b) { return __builtin_bit_cast(float, ((unsigned)b) << 16); }
__device__ __forceinline__ float bflo(unsigned w) { return __builtin_bit_cast(float, w << 16); }
__device__ __forceinline__ float bfhi(unsigned w) { return __builtin_bit_cast(float, w & 0xffff0000u); }
#define LDS_WAIT() asm volatile("s_waitcnt lgkmcnt(0)" ::: "memory")

__device__ __forceinline__ float wave_sum(float v) {
#pragma unroll
    for (int o = 1; o < 64; o <<= 1) v += __shfl_xor(v, o);
    return v;
}
__device__ __forceinline__ float silu_f(float x) { return x / (1.f + expf(-x)); }
__device__ __forceinline__ float silu_fast(float x) { return x * __builtin_amdgcn_rcpf(1.0f + __builtin_amdgcn_exp2f(-1.4426950408889634f * x)); }

__device__ __forceinline__ void rope_cs(int pos, float invf, float& cs, float& sn) {
    const float ang = (float)pos * invf;
    const float k = __builtin_rintf(ang * 0.15915494309189535f);
    float r = __builtin_fmaf(-k, 6.2831854820251465f, ang);
    r = __builtin_fmaf(-k, -1.7484555e-07f, r);
    const float fr = r * 0.15915494309189535f;
    sn = __builtin_amdgcn_sinf(fr); cs = __builtin_amdgcn_cosf(fr);
}
__device__ __forceinline__ float inv_freq_of(int i) { return powf(10000.0f, -(float)i / 64.0f); }

struct Frame {
    LAS unsigned char* lds;
    int tid, lane, wave, vcu, G;
    const float *x, *c, *w_ada, *b_ada, *g_pre_mix, *g_post_mix, *w_in, *conv_w, *w_out, *g_pre_mlp, *g_post_mlp, *w_fc1, *w_fc2;
    const int* positions;
    float* out;
    float *modp, *mod, *invf_tab;
    bf16 *Win_t, *Wout_t, *W1_t, *W2_t, *H, *BIG, *MIXIN, *MIX, *CONVB, *RETB;
};

template <bool PERM_IN = false> __device__ __forceinline__ void p0_transpose_item(const float* W, int K, int N, bf16* WT, LAS float* scr, int item, int lane) {
    const int nblk = N / 32, kb = item / nblk, nb = item % nblk, k0 = 64 * kb, n0 = 32 * nb;
    const int s0 = !PERM_IN ? n0 : (n0 < 1024 ? (((n0 >> 5) & 1) ? 1024 : 0) + 128 * (n0 >> 8) + 32 * ((n0 & 255) >> 6) + (n0 & 31) : (n0 < 1536 ? n0 - 512 : n0));
#pragma unroll 8
    for (int i = 0; i < 32; ++i) { const int kk = 2 * i + (lane >> 5); scr[kk * 33 + (lane & 31)] = W[(size_t)(k0 + kk) * N + s0 + (lane & 31)]; }
    LDS_WAIT(); asm volatile("" ::: "memory");
    const int c = lane & 7;
#pragma unroll
    for (int j = 0; j < 4; ++j) { const int n = (lane >> 3) + 8 * j; const LAS float* s = scr + (8 * c) * 33 + n;
        v4u o; o.x = pk2(s[0 * 33], s[1 * 33]); o.y = pk2(s[2 * 33], s[3 * 33]); o.z = pk2(s[4 * 33], s[5 * 33]); o.w = pk2(s[6 * 33], s[7 * 33]);
        *(GAS v4u*)(WT + (size_t)(n0 + n) * K + k0 + 8 * c) = o; }
    LDS_WAIT(); asm volatile("" ::: "memory");
}
__device__ __forceinline__ void p0_mod_item(const Frame& F, int item, int lane) {
    const int cg = item % (NMOD / 64), ks = item / (NMOD / 64), k0 = ks * (D / KS_MOD), fr = lane & 15, kq = lane >> 4;
    constexpr int KK = D / KS_MOD;
    f32x4 acc[2][4];
#pragma unroll
    for (int mt = 0; mt < 2; ++mt)
#pragma unroll
        for (int nt = 0; nt < 4; ++nt) acc[mt][nt] = (f32x4){0.f, 0.f, 0.f, 0.f};
    const float* cp = F.c + (size_t)fr * D + k0 + kq;
    const float* wp = F.w_ada + (size_t)(k0 + kq) * NMOD + cg * 64 + fr;
    for (int s0 = 0; s0 < KK / 4; s0 += 8) {
        float av[8][2], bv[8][4];
#pragma unroll
        for (int s = 0; s < 8; ++s) {
#pragma unroll
            for (int mt = 0; mt < 2; ++mt) av[s][mt] = cp[(size_t)mt * 16 * D + 4 * (s0 + s)];
#pragma unroll
            for (int nt = 0; nt < 4; ++nt) bv[s][nt] = wp[(size_t)4 * (s0 + s) * NMOD + 16 * nt];
        }
#pragma unroll
        for (int s = 0; s < 8; ++s) {
            const float a0 = silu_fast(av[s][0]), a1 = silu_fast(av[s][1]);
#pragma unroll
            for (int nt = 0; nt < 4; ++nt) { acc[0][nt] = __builtin_amdgcn_mfma_f32_16x16x4f32(a0, bv[s][nt], acc[0][nt], 0, 0, 0);
                                             acc[1][nt] = __builtin_amdgcn_mfma_f32_16x16x4f32(a1, bv[s][nt], acc[1][nt], 0, 0, 0); }
        }
    }
#pragma unroll
    for (int mt = 0; mt < 2; ++mt)
#pragma unroll
        for (int nt = 0; nt < 4; ++nt)
#pragma unroll
            for (int r = 0; r < 4; ++r) F.modp[((size_t)ks * 32 + 16 * mt + 4 * kq + r) * NMOD + cg * 64 + 16 * nt + fr] = acc[mt][nt][r];
}
__device__ __forceinline__ void p0_prologue(const Frame& F) {
    LAS float* scr = (LAS float*)(F.lds + F.wave * 16384);
    if (F.vcu == 0 && F.tid < 64) F.invf_tab[F.tid] = inv_freq_of(F.tid);
    constexpr int I_MOD = (NMOD / 64) * KS_MOD;
    constexpr int I_IN = (D / 64) * (IN_DIM / 32), I_OUT = (D / 64) * (D / 32), I_1 = (D / 64) * (FF / 32), I_2 = (FF / 64) * (D / 32);
    constexpr int NITEMS = I_IN + I_OUT + I_1 + I_2;
    { const int per = (I_MOD + F.G - 1) / F.G; for (int w = F.wave; w < per; w += 8) { const int it = F.vcu * per + w; if (it < I_MOD) p0_mod_item(F, it, F.lane); } }
    const int per_t = (NITEMS + F.G - 1) / F.G, lo = F.vcu * per_t, hi = (lo + per_t < NITEMS) ? lo + per_t : NITEMS;
    volatile LAS unsigned* ctr = (volatile LAS unsigned*)(F.lds + LDS_CTL_OFF_) + 8;
    for (;;) {
        unsigned k = 0;
        if (F.lane == 0) k = __hip_atomic_fetch_add((LAS unsigned*)ctr, 1u, __ATOMIC_RELAXED, __HIP_MEMORY_SCOPE_WORKGROUP);
        const int it = lo + (int)__builtin_amdgcn_readfirstlane(k);
        if (it >= hi) break;
        int r = it;
        if (r < I_IN) { p0_transpose_item<true>(F.w_in, D, IN_DIM, F.Win_t, scr, r, F.lane); continue; } r -= I_IN;
        if (r < I_OUT) { p0_transpose_item(F.w_out, D, D, F.Wout_t, scr, r, F.lane); continue; } r -= I_OUT;
        if (r < I_1) { p0_transpose_item(F.w_fc1, D, FF, F.W1_t, scr, r, F.lane); continue; } r -= I_1;
        p0_transpose_item(F.w_fc2, FF, D, F.W2_t, scr, r, F.lane);
    }
}

__device__ __forceinline__ void p1_h1(const Frame& F) {
    LAS float* modl = (LAS float*)F.lds;
    for (int p = F.vcu; p < M / 256; p += F.G) {
        const int b = p >> 3;
        __syncthreads();
        {
            float s[5]; int jj[5];
#pragma unroll
            for (int q = 0; q < 4; ++q) jj[q] = F.tid + 512 * q;
            jj[4] = 2 * D + (p & 7) * 512 + F.tid;
#pragma unroll
            for (int q = 0; q < 5; ++q) s[q] = F.b_ada[jj[q]];
#pragma unroll
            for (int ks = 0; ks < KS_MOD; ++ks)
#pragma unroll
                for (int q = 0; q < 5; ++q) s[q] += F.modp[((size_t)ks * 32 + b) * NMOD + jj[q]];
#pragma unroll
            for (int q = 0; q < 4; ++q) { modl[jj[q]] = s[q]; if ((jj[q] >> 8) == (p & 7)) F.mod[(size_t)b * NMOD + jj[q]] = s[q]; }
            F.mod[(size_t)b * NMOD + jj[4]] = s[4];
        }
        __syncthreads();
        float a[16], sh[16];
#pragma unroll
        for (int j = 0; j < 4; ++j)
#pragma unroll
            for (int i = 0; i < 4; ++i) { const int col = 4 * (F.lane + 64 * j) + i; a[4 * j + i] = F.g_pre_mix[col] * (1.f + modl[D + col]); sh[4 * j + i] = modl[col]; }
        for (int r = 0; r < 32; ++r) {
            const size_t row = (size_t)p * 256 + F.wave * 32 + r;
            const GAS f32x4* xr = (const GAS f32x4*)(F.x + row * D) + F.lane;
            f32x4 v[4]; float s = 0.f;
#pragma unroll
            for (int j = 0; j < 4; ++j) { v[j] = __builtin_nontemporal_load(xr + 64 * j); s += (v[j].x * v[j].x + v[j].y * v[j].y) + (v[j].z * v[j].z + v[j].w * v[j].w); }
            const float rstd = 1.0f / sqrtf(wave_sum(s) * (1.f / D) + EPS);
            GAS v2u* o8 = (GAS v2u*)(F.H + row * D) + F.lane;
#pragma unroll
            for (int j = 0; j < 4; ++j) { v2u o; o.x = pk2(v[j].x * rstd * a[4 * j + 0] + sh[4 * j + 0], v[j].y * rstd * a[4 * j + 1] + sh[4 * j + 1]);
                o.y = pk2(v[j].z * rstd * a[4 * j + 2] + sh[4 * j + 2], v[j].w * rstd * a[4 * j + 3] + sh[4 * j + 3]); o8[64 * j] = o; }
        }
    }
}

__device__ __forceinline__ void conv_seg16(const Frame& F, int seg, int lane) {
    const bf16* P = F.CONVB;
    const int r0 = seg * 16, s0 = r0 & (SEQ - 1), ch = lane * 8;
    float w0[8], w1[8], w2[8], u1[8], u2[8];
#pragma unroll
    for (int i = 0; i < 8; ++i) { w0[i] = F.conv_w[ch + i]; w1[i] = F.conv_w[CONV + ch + i]; w2[i] = F.conv_w[2 * CONV + ch + i]; u1[i] = 0.f; u2[i] = 0.f; }
    if (s0 != 0) {
#pragma unroll
        for (int k = 0; k < 2; ++k) {
            const v4u uv = __builtin_nontemporal_load((const GAS v4u*)(P + (size_t)(r0 - 2 + k) * 1024 + ch));
            const unsigned uw[4] = {uv.x, uv.y, uv.z, uv.w};
#pragma unroll
            for (int i = 0; i < 4; ++i) { if (k == 0) { u2[2 * i] = bflo(uw[i]); u2[2 * i + 1] = bfhi(uw[i]); } else { u1[2 * i] = bflo(uw[i]); u1[2 * i + 1] = bfhi(uw[i]); } }
        }
    }
    for (int rb = 0; rb < 16; rb += 8) {
        v4u uv[8], bv[8];
#pragma unroll
        for (int r = 0; r < 8; ++r) { const size_t rr = (size_t)(r0 + rb + r) * 1024;
            uv[r] = __builtin_nontemporal_load((const GAS v4u*)(P + rr + ch)); bv[r] = __builtin_nontemporal_load((const GAS v4u*)(P + rr + 512 + ch)); }
#pragma unroll
        for (int r = 0; r < 8; ++r) {
            const unsigned uw[4] = {uv[r].x, uv[r].y, uv[r].z, uv[r].w}, bw[4] = {bv[r].x, bv[r].y, bv[r].z, bv[r].w};
            float y[8];
#pragma unroll
            for (int i = 0; i < 4; ++i) {
                const float ua = bflo(uw[i]), ub = bfhi(uw[i]);
                y[2 * i] = bflo(bw[i]) * (u2[2 * i] * w0[2 * i] + u1[2 * i] * w1[2 * i] + ua * w2[2 * i]);
                y[2 * i + 1] = bfhi(bw[i]) * (u2[2 * i + 1] * w0[2 * i + 1] + u1[2 * i + 1] * w1[2 * i + 1] + ub * w2[2 * i + 1]);
                u2[2 * i] = u1[2 * i]; u2[2 * i + 1] = u1[2 * i + 1]; u1[2 * i] = ua; u1[2 * i + 1] = ub;
            }
            v4u o; o.x = pk2(y[0], y[1]); o.y = pk2(y[2], y[3]); o.z = pk2(y[4], y[5]); o.w = pk2(y[6], y[7]);
            *(GAS v4u*)(F.MIXIN + (size_t)(r0 + rb + r) * D + ch) = o;
        }
    }
}

__device__ __forceinline__ void p5_postmix(const Frame& F) {
    for (int p = F.vcu; p < M / 256; p += F.G) {
        const int b = p >> 3; const float* mod = F.mod + (size_t)b * NMOD;
        float g1[16], a2[16], sh2[16];
#pragma unroll
        for (int j = 0; j < 4; ++j)
#pragma unroll
            for (int i = 0; i < 4; ++i) { const int col = 4 * (F.lane + 64 * j) + i; g1[4 * j + i] = mod[2 * D + col] * F.g_post_mix[col];
                a2[4 * j + i] = F.g_pre_mlp[col] * (1.f + mod[4 * D + col]); sh2[4 * j + i] = mod[3 * D + col]; }
        for (int r = 0; r < 32; ++r) {
            const size_t row = (size_t)p * 256 + F.wave * 32 + r;
            const GAS f32x4* xr = (const GAS f32x4*)(F.x + row * D) + F.lane;
            const GAS v2u* mr = (const GAS v2u*)(F.MIX + row * D) + F.lane;
            f32x4 xv[4], mv[4]; float s = 0.f;
#pragma unroll
            for (int j = 0; j < 4; ++j) { xv[j] = __builtin_nontemporal_load(xr + 64 * j); const v2u m2 = __builtin_nontemporal_load(mr + 64 * j); mv[j] = (f32x4){bflo(m2.x), bfhi(m2.x), bflo(m2.y), bfhi(m2.y)};
                s += (mv[j].x * mv[j].x + mv[j].y * mv[j].y) + (mv[j].z * mv[j].z + mv[j].w * mv[j].w); }
            const float rstd = 1.0f / sqrtf(wave_sum(s) * (1.f / D) + EPS);
            float s2 = 0.f;
#pragma unroll
            for (int j = 0; j < 4; ++j) { xv[j].x += mv[j].x * rstd * g1[4 * j + 0]; xv[j].y += mv[j].y * rstd * g1[4 * j + 1]; xv[j].z += mv[j].z * rstd * g1[4 * j + 2]; xv[j].w += mv[j].w * rstd * g1[4 * j + 3];
                s2 += (xv[j].x * xv[j].x + xv[j].y * xv[j].y) + (xv[j].z * xv[j].z + xv[j].w * xv[j].w); }
            const float rstd2 = 1.0f / sqrtf(wave_sum(s2) * (1.f / D) + EPS);
            GAS v2u* x1b = (GAS v2u*)(F.MIX + row * D) + F.lane;
            GAS v2u* o8 = (GAS v2u*)(F.H + row * D) + F.lane;
#pragma unroll
            for (int j = 0; j < 4; ++j) { v2u xb; xb.x = pk2(xv[j].x, xv[j].y); xb.y = pk2(xv[j].z, xv[j].w); __builtin_nontemporal_store(xb, x1b + 64 * j);
                v2u o; o.x = pk2(xv[j].x * rstd2 * a2[4 * j + 0] + sh2[4 * j + 0], xv[j].y * rstd2 * a2[4 * j + 1] + sh2[4 * j + 1]);
                o.y = pk2(xv[j].z * rstd2 * a2[4 * j + 2] + sh2[4 * j + 2], xv[j].w * rstd2 * a2[4 * j + 3] + sh2[4 * j + 3]); o8[64 * j] = o; }
        }
    }
}
__device__ __forceinline__ void p8_final(const Frame& F) {
    const bf16* Fm = F.MIXIN;
    for (int p = F.vcu; p < M / 256; p += F.G) {
        const int b = p >> 3; const float* mod = F.mod + (size_t)b * NMOD;
        float g2[16];
#pragma unroll
        for (int j = 0; j < 4; ++j)
#pragma unroll
            for (int i = 0; i < 4; ++i) { const int col = 4 * (F.lane + 64 * j) + i; g2[4 * j + i] = mod[5 * D + col] * F.g_post_mlp[col]; }
        for (int r = 0; r < 32; ++r) {
            const size_t row = (size_t)p * 256 + F.wave * 32 + r;
            GAS f32x4* orow = (GAS f32x4*)(F.out + row * D) + F.lane;
            const GAS v2u* mr = (const GAS v2u*)(Fm + row * D) + F.lane;
            const GAS v2u* x1r = (const GAS v2u*)(F.MIX + row * D) + F.lane;
            f32x4 xv[4], mv[4]; float s = 0.f;
#pragma unroll
            for (int j = 0; j < 4; ++j) { const v2u xb = __builtin_nontemporal_load(x1r + 64 * j); xv[j] = (f32x4){bflo(xb.x), bfhi(xb.x), bflo(xb.y), bfhi(xb.y)}; const v2u m2 = __builtin_nontemporal_load(mr + 64 * j); mv[j] = (f32x4){bflo(m2.x), bfhi(m2.x), bflo(m2.y), bfhi(m2.y)};
                s += (mv[j].x * mv[j].x + mv[j].y * mv[j].y) + (mv[j].z * mv[j].z + mv[j].w * mv[j].w); }
            const float rstd = 1.0f / sqrtf(wave_sum(s) * (1.f / D) + EPS);
#pragma unroll
            for (int j = 0; j < 4; ++j) { xv[j].x += mv[j].x * rstd * g2[4 * j + 0]; xv[j].y += mv[j].y * rstd * g2[4 * j + 1]; xv[j].z += mv[j].z * rstd * g2[4 * j + 2]; xv[j].w += mv[j].w * rstd * g2[4 * j + 3];
                __builtin_nontemporal_store(xv[j], orow + 64 * j); }
        }
    }
}


namespace pg8 {
#define PG8_LAS __attribute__((address_space(3)))
typedef unsigned short bf16_t;
typedef short bf16x8 __attribute__((ext_vector_type(8)));
typedef float f32x4 __attribute__((ext_vector_type(4)));
typedef unsigned u32x4 __attribute__((ext_vector_type(4)));
constexpr int BM = 256, BK = 64, HALF = 128, HTB = HALF * BK * 2  , STAGE_BYTES = 8 * HTB, NXCD = 8, WGM = 8;
__host__ __device__ __forceinline__ int lds_byte(int r, int c) { const int st = (r >> 4) * 2 + (c >> 5), rr = r & 15, cc = c & 31, ob = rr * 64 + cc * 2; return st * 1024 + (ob ^ (((ob >> 9) & 1) << 5)); }
__host__ __device__ __forceinline__ void stage_rc(int b, int& R, int& C) { const int st = b / 1024, sb = b % 1024, swz = sb ^ (((sb >> 9) & 1) << 5); R = (st >> 1) * 16 + swz / 64; C = (st & 1) * 32 + (swz % 64) / 2; }
__host__ __device__ __forceinline__ int perm32(int rho) { const int n = rho >> 4, i = rho & 15; return 8 * (i >> 2) + 4 * n + (i & 3); }
struct Unit { int pm, pn; };
struct Gemm { const bf16_t* A; const bf16_t* Bt; int M, N, K; };
struct StaticOrder {
    int nM, nN, nwg, G, c;
    __host__ __device__ void init(int M, int N, int G_, int c_) { nM = M / BM; nN = N / BM; nwg = nM * nN; G = G_; c = c_; }
    __host__ __device__ bool next(int i, Unit& u) const {
        const long L = (long)i * G + c; if (L >= nwg) return false;
        int wgid = (int)L; { const int q = nwg / NXCD, r = nwg % NXCD, xcd = wgid % NXCD, off = wgid / NXCD; wgid = (xcd < r ? xcd * (q + 1) : r * (q + 1) + (xcd - r) * q) + off; }
        const int nig = WGM * nN, gid = wgid / nig, fm = gid * WGM, gsz = (nM - fm) < WGM ? (nM - fm) : WGM;
        u.pm = fm + ((wgid % nig) % gsz); u.pn = (wgid % nig) / gsz; return true;
    }
    __device__ __forceinline__ void a_ready(const Unit&) const {}
    __device__ __forceinline__ void done(const Unit&) const {}
};
__device__ __forceinline__ unsigned cvt_pk_bf16(float lo, float hi) { unsigned r; asm volatile("v_cvt_pk_bf16_f32 %0, %1, %2" : "=v"(r) : "v"(lo), "v"(hi)); return r; }
__device__ __forceinline__ unsigned swap_pair(unsigned x) { return (unsigned)__builtin_amdgcn_mov_dpp((int)x, 0xB1, 0xF, 0xF, true); }
__device__ __forceinline__ u32x4 pack8(const f32x4 v0, const f32x4 v1) { u32x4 w; w.x = cvt_pk_bf16(v0[0], v0[1]); w.y = cvt_pk_bf16(v0[2], v0[3]); w.z = cvt_pk_bf16(v1[0], v1[1]); w.w = cvt_pk_bf16(v1[2], v1[3]); return w; }
__device__ __forceinline__ void pair_rows(const u32x4 w0, const u32x4 w1, bool odd, u32x4& ev, u32x4& od) {
    const u32x4 s0 = {swap_pair(w0.x), swap_pair(w0.y), swap_pair(w0.z), swap_pair(w0.w)}, s1 = {swap_pair(w1.x), swap_pair(w1.y), swap_pair(w1.z), swap_pair(w1.w)};
    ev = odd ? s1 : w0; od = odd ? w1 : s0;
}
template <int ACT  , bool NT = false  > struct EpiBf16 {
    static constexpr bool PERM = true, AFTER_DRAIN = false;
    bf16_t* O; int ldc;
    __device__ __forceinline__ void operator()(const f32x4 (&acc)[2][2][4][2], const Unit& u, int wr, int wc, int fr, int fq) const {
        const bool odd = fr & 1;
        bf16_t* base = O + (size_t)(u.pm * BM + wr * 64 + (fr & ~1)) * ldc + u.pn * BM + wc * 64 + (odd ? 32 : 0) + 8 * fq;
#pragma unroll
        for (int ai = 0; ai < 2; ++ai)
#pragma unroll
            for (int m = 0; m < 4; ++m) { bf16_t* rowp = base + (size_t)(ai * HALF + m * 16) * ldc;
                f32x4 v[2][2];
#pragma unroll
                for (int bj = 0; bj < 2; ++bj)
#pragma unroll
                    for (int n = 0; n < 2; ++n) { v[bj][n] = acc[ai][bj][m][n];
                        if (ACT == 2) {
#pragma unroll
                            for (int j = 0; j < 4; ++j) { const float a0 = v[bj][n][j] > 0.f ? v[bj][n][j] : 0.f; v[bj][n][j] = a0 * a0; } } }
                u32x4 ev, od; pair_rows(pack8(v[0][0], v[0][1]), pack8(v[1][0], v[1][1]), odd, ev, od);
                if (NT) { __builtin_nontemporal_store(ev, (u32x4*)rowp); __builtin_nontemporal_store(od, (u32x4*)(rowp + ldc)); }
                else { *(u32x4*)rowp = ev; *(u32x4*)(rowp + ldc) = od; } }
    }
};

__device__ __forceinline__ float silu_epi(float x) { return x * __builtin_amdgcn_rcpf(1.0f + __builtin_amdgcn_exp2f(-1.4426950408889634f * x)); }
struct EpiProj {
    static constexpr bool PERM = true, AFTER_DRAIN = false;
    bf16_t* CV; bf16_t* RT;
    __device__ __forceinline__ void operator()(const f32x4 (&acc)[2][2][4][2], const Unit& u, int wr, int wc, int fr, int fq) const {
        const int row0 = u.pm * BM + wr * 64;
        if (u.pn < 4) {
            bf16_t* base = CV + (size_t)(row0 + fr) * 1024 + u.pn * HALF + wc * 32 + 8 * fq;
#pragma unroll
            for (int ai = 0; ai < 2; ++ai)
#pragma unroll
                for (int m = 0; m < 4; ++m) __builtin_nontemporal_store(pack8(acc[ai][0][m][0] * acc[ai][1][m][0], acc[ai][0][m][1] * acc[ai][1][m][1]), (u32x4*)(base + (size_t)(ai * HALF + m * 16) * 1024));
            return;
        }
        const bool odd = fr & 1; const int re = row0 + (fr & ~1);
        bf16_t* base; size_t rstride; bool gate = false;
        if (u.pn < 6) { base = CV + (size_t)re * 1024 + 512 + (u.pn - 4) * BM + wc * 64 + (odd ? 32 : 0) + 8 * fq; rstride = 1024; }
        else { const int sec = u.pn - 6, which = sec >> 1, h = (sec & 1) * 2 + (wc >> 1), b = u.pm >> 3, s0 = re & 2047; gate = (which == 3);
               base = RT + ((size_t)(b * 4 + h) * 2048 + s0) * 512 + which * 128 + (wc & 1) * 64 + (odd ? 32 : 0) + 8 * fq; rstride = 512; }
#pragma unroll
        for (int ai = 0; ai < 2; ++ai)
#pragma unroll
            for (int m = 0; m < 4; ++m) { bf16_t* rowp = base + (size_t)(ai * HALF + m * 16) * rstride;
                f32x4 v[2][2];
#pragma unroll
                for (int bj = 0; bj < 2; ++bj)
#pragma unroll
                    for (int n = 0; n < 2; ++n) { v[bj][n] = acc[ai][bj][m][n];
                        if (gate) {
#pragma unroll
                            for (int j = 0; j < 4; ++j) v[bj][n][j] = silu_epi(v[bj][n][j]); } }
                u32x4 ev, od; pair_rows(pack8(v[0][0], v[0][1]), pack8(v[1][0], v[1][1]), odd, ev, od);
                __builtin_nontemporal_store(ev, (u32x4*)rowp); __builtin_nontemporal_store(od, (u32x4*)(rowp + rstride)); }
    }
};

template <class Epi, class Sched, bool ALIGN_EPI = false, bool SP2 = false>
__device__ __forceinline__ void gemm_phase(PG8_LAS unsigned char* lds, const Gemm g, const Sched& S, const Epi& E) {
    int tid_ = threadIdx.x; asm volatile("" : "+v"(tid_));
    const int tid = tid_, wid = __builtin_amdgcn_readfirstlane(tid >> 6), lane = tid & 63, wr = wid >> 2, wc = wid & 3, fr = lane & 15, fq = lane >> 4;
    const int K = g.K, nt = K / BK;
    unsigned voffA[2], voffB[2];
#pragma unroll
    for (int i = 0; i < 2; ++i) { int R, C; stage_rc(tid * 16 + i * 8192, R, C); const int Rb = Epi::PERM ? (64 * (R >> 5) + perm32(R & 31)) : R;
        voffA[i] = (unsigned)(R * K + C) * 2u; voffB[i] = (unsigned)(Rb * K + C) * 2u; }
    const size_t kstep = (size_t)(BK * 2);
    const size_t hstep = (size_t)HALF * K * 2;
    const size_t tstep = 2 * hstep;
    const size_t hstepB = Epi::PERM ? (size_t)32 * K * 2 : hstep;
    const unsigned ldsw = (unsigned)wid * 1024u;
    const int aoff = lds_byte(wr * 64 + fr, fq * 8), boff = lds_byte(wc * 32 + fr, fq * 8);
#define PG8_SA(b, h) (((b) * 2 + (h)) * HTB)
#define PG8_SB(b, h) ((4 + (b) * 2 + (h)) * HTB)
#define PG8_STAGE(bufoff, gbase, voff) do { _Pragma("unroll") for (int _i = 0; _i < 2; ++_i) \
        __builtin_amdgcn_global_load_lds((const unsigned*)((const char*)(gbase) + (voff)[_i]), (PG8_LAS unsigned*)(lds + (bufoff) + ldsw + _i * 8192), 16, 0, 0); } while (0)
#define PG8_LDA(dst, b, h) do { _Pragma("unroll") for (int m = 0; m < 4; ++m) _Pragma("unroll") for (int k = 0; k < 2; ++k) dst[m][k] = *(const PG8_LAS bf16x8*)(lds + PG8_SA(b, h) + aoff + m * 2048 + k * 1024); } while (0)
#define PG8_LDB(dst, b, h) do { _Pragma("unroll") for (int n = 0; n < 2; ++n) _Pragma("unroll") for (int k = 0; k < 2; ++k) dst[n][k] = *(const PG8_LAS bf16x8*)(lds + PG8_SB(b, h) + boff + n * 2048 + k * 1024); } while (0)
#define PG8_MMA(ai, bj, At, Bt) do { __builtin_amdgcn_s_setprio(1); _Pragma("unroll") for (int m = 0; m < 4; ++m) _Pragma("unroll") for (int n = 0; n < 2; ++n) _Pragma("unroll") for (int k = 0; k < 2; ++k) \
        acc[ai][bj][m][n] = __builtin_amdgcn_mfma_f32_16x16x32_bf16(Bt[n][k], At[m][k], acc[ai][bj][m][n], 0, 0, 0); __builtin_amdgcn_s_setprio(0); } while (0)
#define PG8_WAIT_V(n) asm volatile("s_waitcnt vmcnt(" #n ")" ::: "memory")
#define PG8_WAIT_L(n) asm volatile("s_waitcnt lgkmcnt(" #n ")" ::: "memory")
#define PG8_BAR __builtin_amdgcn_s_barrier()
#define PG8_SCHED __builtin_amdgcn_sched_barrier(0)
    Unit cur, nxt; int ui = 0;
    if (!S.next(0, cur)) return;
    f32x4 acc[2][2][4][2];
#pragma unroll
    for (int a = 0; a < 2; ++a)
#pragma unroll
        for (int b = 0; b < 2; ++b)
#pragma unroll
            for (int m = 0; m < 4; ++m)
#pragma unroll
                for (int n = 0; n < 2; ++n) acc[a][b][m][n] = (f32x4){0.f, 0.f, 0.f, 0.f};
    bf16x8 At[4][2], B0[2][2], B1[2][2];
    const char* cA = (const char*)g.A + (size_t)cur.pm * tstep; const char* cB = (const char*)g.Bt + (size_t)cur.pn * tstep;
    S.a_ready(cur);
    if constexpr (SP2) {
        PG8_STAGE(PG8_SB(0, 0), cB, voffB); PG8_STAGE(PG8_SB(0, 1), cB + hstepB, voffB); PG8_STAGE(PG8_SA(0, 0), cA, voffA); PG8_STAGE(PG8_SA(0, 1), cA + hstep, voffA);
        if (wr == 1) PG8_BAR;
        PG8_WAIT_V(2); PG8_BAR;
        PG8_STAGE(PG8_SB(1, 0), cB + kstep, voffB); PG8_STAGE(PG8_SA(1, 0), cA + kstep, voffA); PG8_STAGE(PG8_SB(1, 1), cB + hstepB + kstep, voffB);
        PG8_WAIT_V(6); PG8_BAR;
    } else {
        PG8_STAGE(PG8_SB(0, 0), cB, voffB); PG8_STAGE(PG8_SA(0, 0), cA, voffA); PG8_STAGE(PG8_SB(0, 1), cB + hstepB, voffB); PG8_STAGE(PG8_SA(0, 1), cA + hstep, voffA);
        if (wr == 1) PG8_BAR;
        PG8_WAIT_V(4); PG8_BAR;
        PG8_STAGE(PG8_SB(1, 0), cB + kstep, voffB); PG8_STAGE(PG8_SA(1, 0), cA + kstep, voffA); PG8_STAGE(PG8_SB(1, 1), cB + hstepB + kstep, voffB);
        PG8_WAIT_V(6); PG8_BAR;
    }
    for (;;) {
        const bool has_next = S.next(ui + 1, nxt);
        const char* nA = has_next ? (const char*)g.A + (size_t)nxt.pm * tstep : cA; const char* nB = has_next ? (const char*)g.Bt + (size_t)nxt.pn * tstep : cB;
        for (int t = 0; t < nt; t += 2) {
            const bool last = (t == nt - 2);
            const char* a1 = cA + (size_t)(t + 1) * kstep;
            const char* a2 = last ? nA : cA + (size_t)(t + 2) * kstep; const char* b2 = last ? nB : cB + (size_t)(t + 2) * kstep;
            const char* a3 = a2 + kstep; const char* b3 = b2 + kstep;
            if (last && has_next) S.a_ready(nxt);
            if constexpr (SP2) {
            PG8_LDB(B0, 0, 0); PG8_LDB(B1, 0, 1); PG8_SCHED; PG8_LDA(At, 0, 0); PG8_STAGE(PG8_SA(1, 1), a1 + hstep, voffA);
            PG8_WAIT_V(8); PG8_WAIT_L(0); PG8_BAR; PG8_MMA(0, 0, At, B0); PG8_MMA(0, 1, At, B1); PG8_BAR; PG8_SCHED;
            PG8_LDA(At, 0, 1); PG8_STAGE(PG8_SB(0, 0), b2, voffB); PG8_STAGE(PG8_SB(0, 1), b2 + hstepB, voffB); PG8_STAGE(PG8_SA(0, 0), a2, voffA);
            PG8_WAIT_V(8); PG8_WAIT_L(0); PG8_BAR; PG8_MMA(1, 0, At, B0); PG8_MMA(1, 1, At, B1); PG8_BAR; PG8_SCHED;
            PG8_LDB(B0, 1, 0); PG8_LDB(B1, 1, 1); PG8_SCHED; PG8_LDA(At, 1, 0); PG8_STAGE(PG8_SA(0, 1), a2 + hstep, voffA);
            PG8_WAIT_V(8); PG8_WAIT_L(0); PG8_BAR; PG8_MMA(0, 0, At, B0); PG8_MMA(0, 1, At, B1); PG8_BAR; PG8_SCHED;
            PG8_LDA(At, 1, 1); PG8_STAGE(PG8_SB(1, 0), b3, voffB); PG8_STAGE(PG8_SB(1, 1), b3 + hstepB, voffB); PG8_STAGE(PG8_SA(1, 0), a3, voffA);
            PG8_WAIT_V(8); PG8_WAIT_L(0); PG8_BAR; PG8_MMA(1, 0, At, B0); PG8_MMA(1, 1, At, B1); PG8_BAR; PG8_SCHED;
            } else {
            PG8_LDB(B0, 0, 0); PG8_SCHED; PG8_LDA(At, 0, 0); PG8_STAGE(PG8_SA(1, 1), a1 + hstep, voffA);
            PG8_WAIT_L(8); PG8_BAR; PG8_WAIT_L(0); PG8_MMA(0, 0, At, B0); PG8_BAR; PG8_SCHED;
            PG8_LDB(B1, 0, 1); PG8_STAGE(PG8_SB(0, 0), b2, voffB);
            PG8_BAR; PG8_WAIT_L(0); PG8_MMA(0, 1, At, B1); PG8_BAR;
            PG8_LDA(At, 0, 1); PG8_STAGE(PG8_SA(0, 0), a2, voffA);
            PG8_BAR; PG8_WAIT_L(0); PG8_MMA(1, 0, At, B0); PG8_BAR; PG8_SCHED;
            PG8_STAGE(PG8_SB(0, 1), b2 + hstepB, voffB);
            PG8_WAIT_V(6); PG8_BAR; PG8_MMA(1, 1, At, B1); PG8_BAR;
            PG8_LDB(B0, 1, 0); PG8_SCHED; PG8_LDA(At, 1, 0); PG8_STAGE(PG8_SA(0, 1), a2 + hstep, voffA);
            PG8_WAIT_L(8); PG8_BAR; PG8_WAIT_L(0); PG8_MMA(0, 0, At, B0); PG8_BAR; PG8_SCHED;
            PG8_LDB(B1, 1, 1); PG8_STAGE(PG8_SB(1, 0), b3, voffB);
            PG8_BAR; PG8_WAIT_L(0); PG8_MMA(0, 1, At, B1); PG8_BAR;
            PG8_LDA(At, 1, 1); PG8_STAGE(PG8_SA(1, 0), a3, voffA);
            PG8_BAR; PG8_WAIT_L(0); PG8_MMA(1, 0, At, B0); PG8_BAR; PG8_SCHED;
            PG8_STAGE(PG8_SB(1, 1), b3 + hstepB, voffB);
            PG8_WAIT_V(6); PG8_BAR; PG8_MMA(1, 1, At, B1); PG8_BAR;
            }
        }
        if constexpr (ALIGN_EPI) { if (wr == 0) PG8_BAR; }
        if constexpr (!Epi::AFTER_DRAIN) { E(acc, cur, wr, wc, fr, fq); S.done(cur); }
        if (!has_next) break;
#pragma unroll
        for (int a = 0; a < 2; ++a)
#pragma unroll
            for (int b = 0; b < 2; ++b)
#pragma unroll
                for (int m = 0; m < 4; ++m)
#pragma unroll
                    for (int n = 0; n < 2; ++n) acc[a][b][m][n] = (f32x4){0.f, 0.f, 0.f, 0.f};
        cur = nxt; cA = nA; cB = nB; ++ui;
        if constexpr (ALIGN_EPI) { if (wr == 1) PG8_BAR; }
    }
    PG8_WAIT_V(0);
    if constexpr (!ALIGN_EPI) { if (wr == 0) PG8_BAR; }
    PG8_BAR;
    if constexpr (Epi::AFTER_DRAIN) { E.fused(acc, cur, wr, wc, fr, fq, lds, wid, lane); S.done(cur); }
#undef PG8_SA
#undef PG8_SB
#undef PG8_STAGE
#undef PG8_LDA
#undef PG8_LDB
#undef PG8_MMA
#undef PG8_WAIT_V
#undef PG8_WAIT_L
#undef PG8_BAR
#undef PG8_SCHED
}
}

typedef short s16x4 __attribute__((ext_vector_type(4)));
__device__ __forceinline__ unsigned off_q(unsigned row, unsigned ch) { return 256u * row + 16u * (ch ^ (row & 15u)); }
__device__ __forceinline__ unsigned off_b(unsigned row, unsigned ch) { return 256u * row + 16u * (ch ^ (((row & 3u) << 2) | ((row >> 2) & 3u))); }
__device__ __forceinline__ bf16x8 tr_frag(LAS unsigned char* base, unsigned a0, unsigned a1) {
    const s16x4 x = __builtin_amdgcn_ds_read_tr16_b64_v4i16((LAS s16x4*)(base + a0));
    const s16x4 y = __builtin_amdgcn_ds_read_tr16_b64_v4i16((LAS s16x4*)(base + a1));
    return __builtin_shufflevector(x, y, 0, 1, 2, 3, 4, 5, 6, 7);
}
constexpr unsigned RT_QKV = 49152, RT_ST = 98304, RT_ST_STR = 272, RT_PS = RT_ST + 128 * RT_ST_STR, RT_PS_STR = 144, RT_RED = RT_PS + 64 * RT_PS_STR, RT_END = RT_RED + 1024;
struct RetLoads { v4u q1, q2, k1, k2, v1, v2; int pos; };
template <bool WQ> __device__ __forceinline__ void ret_issue_loads(RetLoads& R, const bf16* gq, const int* ppos) {
    if (WQ) { R.q1 = __builtin_nontemporal_load((const GAS v4u*)(gq)); R.q2 = __builtin_nontemporal_load((const GAS v4u*)(gq + 64)); }
    R.k1 = __builtin_nontemporal_load((const GAS v4u*)(gq + 128)); R.k2 = __builtin_nontemporal_load((const GAS v4u*)(gq + 128 + 64));
    R.v1 = __builtin_nontemporal_load((const GAS v4u*)(gq + 256)); R.v2 = __builtin_nontemporal_load((const GAS v4u*)(gq + 256 + 64));
    R.pos = *ppos;
}
template <bool WQ> __device__ __forceinline__ void ret_stage_write(const RetLoads& R, LAS unsigned char* Qb, int srow, int sch, const float (&invf)[8], float vdec) {
    const unsigned k1w[4] = {R.k1.x, R.k1.y, R.k1.z, R.k1.w}, k2w[4] = {R.k2.x, R.k2.y, R.k2.z, R.k2.w};
    const unsigned v1w[4] = {R.v1.x, R.v1.y, R.v1.z, R.v1.w}, v2w[4] = {R.v2.x, R.v2.y, R.v2.z, R.v2.w};
    unsigned oq1[4], oq2[4], ok1[4], ok2[4], ov1[4], ov2[4];
    constexpr float KSC = 0.08838834764831845f;
#pragma unroll
    for (int i = 0; i < 4; ++i) {
        float c0, s0, c1, s1; rope_cs(R.pos, invf[2 * i], c0, s0); rope_cs(R.pos, invf[2 * i + 1], c1, s1);
        if (WQ) { const unsigned q1w[4] = {R.q1.x, R.q1.y, R.q1.z, R.q1.w}, q2w[4] = {R.q2.x, R.q2.y, R.q2.z, R.q2.w};
            const float qa0 = bflo(q1w[i]), qa1 = bfhi(q1w[i]), qb0 = bflo(q2w[i]), qb1 = bfhi(q2w[i]);
            oq1[i] = pk2(qa0 * c0 - qb0 * s0, qa1 * c1 - qb1 * s1); oq2[i] = pk2(qb0 * c0 + qa0 * s0, qb1 * c1 + qa1 * s1); }
        const float ka0 = bflo(k1w[i]), ka1 = bfhi(k1w[i]), kb0 = bflo(k2w[i]), kb1 = bfhi(k2w[i]);
        ok1[i] = pk2((ka0 * c0 - kb0 * s0) * KSC, (ka1 * c1 - kb1 * s1) * KSC); ok2[i] = pk2((kb0 * c0 + ka0 * s0) * KSC, (kb1 * c1 + ka1 * s1) * KSC);
        ov1[i] = pk2(bflo(v1w[i]) * vdec, bfhi(v1w[i]) * vdec); ov2[i] = pk2(bflo(v2w[i]) * vdec, bfhi(v2w[i]) * vdec);
    }
    const unsigned o1 = off_b(srow, sch), o2 = off_b(srow, sch + 8);
    if (WQ) { *(LAS v4u*)(Qb + off_q(srow, sch)) = (v4u){oq1[0], oq1[1], oq1[2], oq1[3]}; *(LAS v4u*)(Qb + off_q(srow, sch + 8)) = (v4u){oq2[0], oq2[1], oq2[2], oq2[3]}; }
    *(LAS v4u*)(Qb + 16384 + o1) = (v4u){ok1[0], ok1[1], ok1[2], ok1[3]}; *(LAS v4u*)(Qb + 16384 + o2) = (v4u){ok2[0], ok2[1], ok2[2], ok2[3]};
    *(LAS v4u*)(Qb + 32768 + o1) = (v4u){ov1[0], ov1[1], ov1[2], ov1[3]}; *(LAS v4u*)(Qb + 32768 + o2) = (v4u){ov2[0], ov2[1], ov2[2], ov2[3]};
}
__device__ __forceinline__ void ret_unit(const Frame& F, int unit, int n0, int n1) {
    LAS unsigned char* L = F.lds;
    int t_ = threadIdx.x; asm volatile("" : "+v"(t_));
    const int t = t_, l = t & 63, w = __builtin_amdgcn_readfirstlane(t >> 6), g = l >> 4, fr = l & 15, q4 = fr >> 2, p4 = l & 3, cw = w >> 2, ew = w & 3;
    const int b = unit >> 2, h = unit & 3;
    const float lg = log1pf(-exp2f(-5.0f - (float)h));
    float maskp[2][4], qd[2];
#pragma unroll
    for (int ct = 0; ct < 2; ++ct) { const int c = 16 * (2 * cw + ct) + fr; qd[ct] = expf(lg * (float)(c + 1));
#pragma unroll
        for (int r = 0; r < 4; ++r) { const int m = 16 * ew + 4 * g + r; const int ad = c > m ? c - m : m - c; maskp[ct][r] = expf(lg * (float)(ad - 63 + m)); } }
    const float cdec = expf(lg * 64.0f);
    const int srow = t >> 3, sch = t & 7;
    const float vdec = expf(lg * (float)(63 - srow));
    float invf[8];
    { const f32x4 fa = *(const f32x4*)(F.invf_tab + sch * 8), fb = *(const f32x4*)(F.invf_tab + sch * 8 + 4);
      invf[0] = fa[0]; invf[1] = fa[1]; invf[2] = fa[2]; invf[3] = fa[3]; invf[4] = fb[0]; invf[5] = fb[1]; invf[6] = fb[2]; invf[7] = fb[3]; }
    const size_t row0 = (size_t)b * SEQ;
    const bf16* rt = F.RETB + (size_t)unit * SEQ * 512;
    const bf16* gq = rt + (size_t)srow * 512 + sch * 8;
    const int* ppos = F.positions + row0 + srow;
    f32x4 acc4[4][2];
#pragma unroll
    for (int dt = 0; dt < 4; ++dt)
#pragma unroll
        for (int et = 0; et < 2; ++et) acc4[dt][et] = (f32x4){0.f, 0.f, 0.f, 0.f};
    __syncthreads();
    if (n0 > 0) {
        { RetLoads R; ret_issue_loads<false>(R, gq, ppos); ret_stage_write<false>(R, L, srow, sch, invf, vdec); }
        __syncthreads();
        RetLoads PA, PB;
        if (1 < n0) ret_issue_loads<false>(PA, gq + (size_t)CH * 512, ppos + CH);
#define RET_PRE(n, PST, PLD) { \
            LAS unsigned char* Kb = L + ((n) & 1) * RT_QKV + 16384; LAS unsigned char* Vb = Kb + 16384; \
            if ((n) + 2 < n0) ret_issue_loads<false>(PLD, gq + (size_t)((n) + 2) * CH * 512, ppos + ((n) + 2) * CH); \
            _Pragma("unroll") for (int dt = 0; dt < 4; ++dt) _Pragma("unroll") for (int et = 0; et < 2; ++et) acc4[dt][et] = acc4[dt][et] * cdec; \
            _Pragma("unroll") for (int s = 0; s < 2; ++s) { \
                bf16x8 vfp[2]; \
                _Pragma("unroll") for (int et = 0; et < 2; ++et) { const unsigned ch = 2 * (2 * ew + et) + (p4 >> 1), r0 = 32 * s + 8 * g + q4; \
                    vfp[et] = tr_frag(Vb, off_b(r0, ch) + 8 * (p4 & 1), off_b(r0 + 4, ch) + 8 * (p4 & 1)); } \
                _Pragma("unroll") for (int dt = 0; dt < 4; ++dt) { const unsigned ch = 2 * (4 * cw + dt) + (p4 >> 1), r0 = 32 * s + 8 * g + q4; \
                    const bf16x8 kt = tr_frag(Kb, off_b(r0, ch) + 8 * (p4 & 1), off_b(r0 + 4, ch) + 8 * (p4 & 1)); \
                    _Pragma("unroll") for (int et = 0; et < 2; ++et) acc4[dt][et] = __builtin_amdgcn_mfma_f32_16x16x32_bf16(kt, vfp[et], acc4[dt][et], 0, 0, 0); } \
            } \
            if ((n) + 1 < n0) ret_stage_write<false>(PST, L + (((n) + 1) & 1) * RT_QKV, srow, sch, invf, vdec); \
            __syncthreads(); }
        for (int n = 0; n < n0; n += 2) { RET_PRE(n, PA, PB) { const int n_odd = n + 1; RET_PRE(n_odd, PB, PA) } }
#undef RET_PRE
#pragma unroll
        for (int dt = 0; dt < 4; ++dt)
#pragma unroll
            for (int et = 0; et < 2; ++et) { v2u sw; sw.x = pk2(acc4[dt][et][0], acc4[dt][et][1]); sw.y = pk2(acc4[dt][et][2], acc4[dt][et][3]);
                *(LAS v2u*)(L + RT_ST + (16 * (2 * ew + et) + fr) * RT_ST_STR + (16 * (4 * cw + dt) + 4 * g) * 2) = sw; }
    } else {
        for (int i = t; i < (128 * (int)RT_ST_STR) / 4; i += 512) ((LAS unsigned*)(L + RT_ST))[i] = 0u;
    }
    { RetLoads R; ret_issue_loads<true>(R, gq + (size_t)n0 * CH * 512, ppos + n0 * CH); ret_stage_write<true>(R, L + (n0 & 1) * RT_QKV, srow, sch, invf, vdec); }
    __syncthreads();
    v2u gv[2][2];
#pragma unroll
    for (int ct = 0; ct < 2; ++ct)
#pragma unroll
        for (int et = 0; et < 2; ++et) gv[ct][et] = *(const GAS v2u*)(rt + ((size_t)n0 * CH + 16 * (2 * cw + ct) + fr) * 512 + 384 + 16 * (2 * ew + et) + 4 * g);
    for (int n = n0; n < n1; ++n) {
        LAS unsigned char* Qb = L + (n & 1) * RT_QKV; LAS unsigned char* Kb = Qb + 16384; LAS unsigned char* Vb = Qb + 32768;
        const bool has_next = (n + 1 < n1);
        RetLoads R;
        if (has_next) ret_issue_loads<true>(R, gq + (size_t)(n + 1) * CH * 512, ppos + (n + 1) * CH);
        v2u gvn[2][2];
        if (has_next) {
#pragma unroll
            for (int ct = 0; ct < 2; ++ct)
#pragma unroll
                for (int et = 0; et < 2; ++et)
                    gvn[ct][et] = *(const GAS v2u*)(rt + ((size_t)(n + 1) * CH + 16 * (2 * cw + ct) + fr) * 512 + 384 + 16 * (2 * ew + et) + 4 * g);
        }
        bf16x8 qf[2][4];
#pragma unroll
        for (int ct = 0; ct < 2; ++ct)
#pragma unroll
            for (int s = 0; s < 4; ++s) qf[ct][s] = *(const LAS bf16x8*)(Qb + off_q(16 * (2 * cw + ct) + fr, 4 * s + g));
        f32x4 a1[2] = {(f32x4){0.f, 0.f, 0.f, 0.f}, (f32x4){0.f, 0.f, 0.f, 0.f}};
#pragma unroll
        for (int s = 0; s < 4; ++s) { const bf16x8 kf = *(const LAS bf16x8*)(Kb + off_b(16 * ew + fr, 4 * s + g));
#pragma unroll
            for (int ct = 0; ct < 2; ++ct) a1[ct] = __builtin_amdgcn_mfma_f32_16x16x32_bf16(kf, qf[ct][s], a1[ct], 0, 0, 0); }
#pragma unroll
        for (int ct = 0; ct < 2; ++ct) { v2u pw; pw.x = pk2(a1[ct][0] * maskp[ct][0], a1[ct][1] * maskp[ct][1]); pw.y = pk2(a1[ct][2] * maskp[ct][2], a1[ct][3] * maskp[ct][3]);
            *(LAS v2u*)(L + RT_PS + (16 * (2 * cw + ct) + fr) * RT_PS_STR + (16 * ew + 4 * g) * 2) = pw; }
        f32x4 aX[2][2], aI[2][2];
#pragma unroll
        for (int ct = 0; ct < 2; ++ct)
#pragma unroll
            for (int et = 0; et < 2; ++et) { aX[ct][et] = (f32x4){0.f, 0.f, 0.f, 0.f}; aI[ct][et] = (f32x4){0.f, 0.f, 0.f, 0.f}; }
#pragma unroll
        for (int s = 0; s < 4; ++s)
#pragma unroll
            for (int et = 0; et < 2; ++et) { const bf16x8 sf = *(const LAS bf16x8*)(L + RT_ST + (16 * (2 * ew + et) + fr) * RT_ST_STR + (32 * s + 8 * g) * 2);
#pragma unroll
                for (int ct = 0; ct < 2; ++ct) aX[ct][et] = __builtin_amdgcn_mfma_f32_16x16x32_bf16(sf, qf[ct][s], aX[ct][et], 0, 0, 0); }
        __syncthreads();
        bf16x8 vf[2][2];
#pragma unroll
        for (int et = 0; et < 2; ++et)
#pragma unroll
            for (int s = 0; s < 2; ++s) { const unsigned ch = 2 * (2 * ew + et) + (p4 >> 1), r0 = 32 * s + 8 * g + q4;
                vf[et][s] = tr_frag(Vb, off_b(r0, ch) + 8 * (p4 & 1), off_b(r0 + 4, ch) + 8 * (p4 & 1)); }
#pragma unroll
        for (int s = 0; s < 2; ++s)
#pragma unroll
            for (int ct = 0; ct < 2; ++ct) { const bf16x8 pf = *(const LAS bf16x8*)(L + RT_PS + (16 * (2 * cw + ct) + fr) * RT_PS_STR + (32 * s + 8 * g) * 2);
#pragma unroll
                for (int et = 0; et < 2; ++et) aI[ct][et] = __builtin_amdgcn_mfma_f32_16x16x32_bf16(vf[et][s], pf, aI[ct][et], 0, 0, 0); }
#pragma unroll
        for (int dt = 0; dt < 4; ++dt)
#pragma unroll
            for (int et = 0; et < 2; ++et) acc4[dt][et] = acc4[dt][et] * cdec;
#pragma unroll
        for (int s = 0; s < 2; ++s)
#pragma unroll
            for (int dt = 0; dt < 4; ++dt) { const unsigned ch = 2 * (4 * cw + dt) + (p4 >> 1), r0 = 32 * s + 8 * g + q4;
                const bf16x8 kt = tr_frag(Kb, off_b(r0, ch) + 8 * (p4 & 1), off_b(r0 + 4, ch) + 8 * (p4 & 1));
#pragma unroll
                for (int et = 0; et < 2; ++et) acc4[dt][et] = __builtin_amdgcn_mfma_f32_16x16x32_bf16(kt, vf[et][s], acc4[dt][et], 0, 0, 0); }
#pragma unroll
        for (int dt = 0; dt < 4; ++dt)
#pragma unroll
            for (int et = 0; et < 2; ++et) { v2u sw; sw.x = pk2(acc4[dt][et][0], acc4[dt][et][1]); sw.y = pk2(acc4[dt][et][2], acc4[dt][et][3]);
                *(LAS v2u*)(L + RT_ST + (16 * (2 * ew + et) + fr) * RT_ST_STR + (16 * (4 * cw + dt) + 4 * g) * 2) = sw; }
#pragma unroll
        for (int ct = 0; ct < 2; ++ct) { float ss = 0.f;
#pragma unroll
            for (int et = 0; et < 2; ++et) { aI[ct][et] = aI[ct][et] + aX[ct][et] * qd[ct];
                ss += (aI[ct][et][0] * aI[ct][et][0] + aI[ct][et][1] * aI[ct][et][1]) + (aI[ct][et][2] * aI[ct][et][2] + aI[ct][et][3] * aI[ct][et][3]); }
            ss += __shfl_xor(ss, 16); ss += __shfl_xor(ss, 32);
            if (g == 0) ((LAS float*)(L + RT_RED))[(16 * (2 * cw + ct) + fr) * 4 + ew] = ss; }
        if (has_next) ret_stage_write<true>(R, L + ((n + 1) & 1) * RT_QKV, srow, sch, invf, vdec);
        __syncthreads();
#pragma unroll
        for (int ct = 0; ct < 2; ++ct) { const int c = 16 * (2 * cw + ct) + fr; const f32x4 rs = *(const LAS f32x4*)(L + RT_RED + c * 16);
            const float rstd = 1.0f / sqrtf(((rs.x + rs.y) + (rs.z + rs.w)) * (1.f / 128.f) + EPS);
#pragma unroll
            for (int et = 0; et < 2; ++et) { const v2u gg = gv[ct][et];
                v2u o; o.x = pk2(bflo(gg.x) * aI[ct][et][0] * rstd, bfhi(gg.x) * aI[ct][et][1] * rstd);
                o.y = pk2(bflo(gg.y) * aI[ct][et][2] * rstd, bfhi(gg.y) * aI[ct][et][3] * rstd);
                *(GAS v2u*)(F.MIXIN + (row0 + (size_t)n * CH + c) * D + CONV + h * DH + 16 * (2 * ew + et) + 4 * g) = o; } }
        if (has_next) {
#pragma unroll
            for (int ct = 0; ct < 2; ++ct)
#pragma unroll
                for (int et = 0; et < 2; ++et) gv[ct][et] = gvn[ct][et];
        }
    }
}

#define XB_TMO      128
#define XB_XCNT(j)  (256  + 64 * (j))
#define XB_XSUB(j)  (1280 + 64 * (j))
#define XB_XGEN(j)  (2304 + 64 * (j))
#define XB_TOP      3328
#define XB_TOPGEN   3392
#define XCD_BAR_WORDS 3456
#define XB_SPIN_CAP (1u << 18)

__device__ __forceinline__ unsigned xb_ld(unsigned* p)              { return __hip_atomic_load(p, __ATOMIC_RELAXED, __HIP_MEMORY_SCOPE_AGENT); }
__device__ __forceinline__ unsigned xb_add(unsigned* p, unsigned v) { return __hip_atomic_fetch_add(p, v, __ATOMIC_RELAXED, __HIP_MEMORY_SCOPE_AGENT); }
__device__ __forceinline__ unsigned xb_xcc_id() { return (unsigned)__builtin_amdgcn_s_getreg((3 << 11) | 20) & 0xFu; }
#define XB_SPIN(cond, bar) do { unsigned _sp = 0; while (cond) { __builtin_amdgcn_s_sleep(1); \
    if ((++_sp & 255u) == 0u) { if (xb_ld(&(bar)[XB_TMO])) break; if (_sp > XB_SPIN_CAP) { atomicAdd(&(bar)[XB_TMO], 1u); break; } } } } while (0)

struct XcdBarrier {
    unsigned* bar; unsigned x;
    volatile LAS unsigned* st;
};

__device__ __forceinline__ XcdBarrier xcd_barrier_post(unsigned* bar, volatile LAS unsigned* st) {
    XcdBarrier b; b.bar = bar; b.x = xb_xcc_id(); b.st = st;
    if (threadIdx.x == 0) (void)xb_add(&bar[XB_XCNT(b.x)], 1u);
    return b;
}
__device__ __forceinline__ void xcd_barrier_complete(unsigned* bar, unsigned x, unsigned& nloc, unsigned& nx) {
    const unsigned G = gridDim.x * gridDim.y * gridDim.z;
    unsigned sum, cnt, mine, sp = 0u;
    for (;;) {
        sum = 0u; cnt = 0u; mine = 0u;
#pragma unroll
        for (unsigned j = 0; j < 16; ++j) { const unsigned c = xb_ld(&bar[XB_XCNT(j)]); sum += c; cnt += (c > 0u) ? 1u : 0u; mine = (j == x) ? c : mine; }
        if (sum == G) break;
        __builtin_amdgcn_s_sleep(1);
        if ((++sp & 255u) == 0u) { if (xb_ld(&bar[XB_TMO])) break; if (sp > XB_SPIN_CAP) { atomicAdd(&bar[XB_TMO], 1u); break; } }
    }
    nloc = mine > 0u ? mine : 1u; nx = cnt > 0u ? cnt : 1u;
}

__device__ __forceinline__ void xcd_barrier(const XcdBarrier& b) {
    asm volatile("s_waitcnt vmcnt(0)" ::: "memory");
    __syncthreads();
    if (threadIdx.x == 0) {
        unsigned* bar = b.bar;
        __builtin_amdgcn_s_waitcnt(0);
        unsigned nloc = b.st[0], nx = b.st[1];
        if (nloc == 0u) { xcd_barrier_complete(bar, b.x, nloc, nx); b.st[0] = nloc; b.st[1] = nx; }
        const unsigned old = xb_add(&bar[XB_XSUB(b.x)], 1u);
        const unsigned gen = old / nloc;
        if (old + 1u == (gen + 1u) * nloc) {
            __builtin_amdgcn_fence(__ATOMIC_RELEASE, "agent");
            asm volatile("s_waitcnt vmcnt(0)" ::: "memory");
            const unsigned og = xb_add(&bar[XB_TOP], 1u);
            const unsigned tg = og / nx;
            if (og + 1u == (tg + 1u) * nx) xb_add(&bar[XB_TOPGEN], 1u);
            else XB_SPIN(xb_ld(&bar[XB_TOPGEN]) == tg, bar);
            __builtin_amdgcn_fence(__ATOMIC_ACQUIRE, "agent");
            xb_add(&bar[XB_XGEN(b.x)], 1u);
            asm volatile("s_waitcnt vmcnt(0)" ::: "memory");
        } else {
            XB_SPIN(xb_ld(&bar[XB_XGEN(b.x)]) == gen, bar);
            __builtin_amdgcn_fence(__ATOMIC_ACQUIRE, "agent");
            asm volatile("s_waitcnt vmcnt(0)" ::: "memory");
        }
    }
    __syncthreads();
}

constexpr int LDS_BYTES = 147456;
constexpr int LDS_CTL_OFF = 147456 - 64;
struct Args { const void* in[14]; float* out; unsigned char* ws; };
__device__ __forceinline__ Frame make_frame(const Args& a, LAS unsigned char* lds) {
    Frame F; F.lds = lds; F.tid = threadIdx.x; F.lane = F.tid & 63; F.wave = __builtin_amdgcn_readfirstlane(F.tid >> 6);
    F.G = gridDim.x; { const int bx = blockIdx.x; F.vcu = (F.G % 8 == 0) ? (bx % 8) * (F.G / 8) + bx / 8 : bx; }
    F.x = (const float*)a.in[0]; F.c = (const float*)a.in[1]; F.positions = (const int*)a.in[2]; F.w_ada = (const float*)a.in[3]; F.b_ada = (const float*)a.in[4];
    F.g_pre_mix = (const float*)a.in[5]; F.g_post_mix = (const float*)a.in[6]; F.w_in = (const float*)a.in[7]; F.conv_w = (const float*)a.in[8]; F.w_out = (const float*)a.in[9];
    F.g_pre_mlp = (const float*)a.in[10]; F.g_post_mlp = (const float*)a.in[11]; F.w_fc1 = (const float*)a.in[12]; F.w_fc2 = (const float*)a.in[13];
    F.out = a.out; unsigned char* ws = a.ws;
    F.modp = (float*)(ws + WS_MODP); F.mod = (float*)(ws + WS_MOD); F.invf_tab = (float*)(ws + WS_MOD + 1 * MiB);
    F.Win_t = (bf16*)(ws + WS_WIN); F.Wout_t = (bf16*)(ws + WS_WOUT); F.W1_t = (bf16*)(ws + WS_W1); F.W2_t = (bf16*)(ws + WS_W2);
    F.H = (bf16*)(ws + WS_H); F.BIG = (bf16*)(ws + WS_BIG); F.MIXIN = (bf16*)(ws + WS_MIXIN); F.MIX = (bf16*)(ws + WS_MIX);
    F.CONVB = F.BIG; F.RETB = F.BIG + (size_t)M * 1024;
    return F;
}
__global__ void __launch_bounds__(512, 2) mk_fwd(Args a) {
    extern __shared__ __attribute__((aligned(16))) unsigned char lds[];
    cg::grid_group grid = cg::this_grid();
    Frame F = make_frame(a, (LAS unsigned char*)lds);
    volatile LAS unsigned* bst = (volatile LAS unsigned*)(F.lds + LDS_CTL_OFF);
    if (F.tid < 16) bst[F.tid] = 0u;
    __syncthreads();
    const XcdBarrier xb = xcd_barrier_post((unsigned*)(a.ws + WS_CTL), bst);
    p0_prologue(F);
    grid.sync();
    p1_h1(F);
    xcd_barrier(xb);
    { pg8::Gemm g{F.H, F.Win_t, M, IN_DIM, D}; pg8::StaticOrder S; S.init(M, IN_DIM, F.G, (int)blockIdx.x); pg8::EpiProj E{F.CONVB, F.RETB};
      pg8::gemm_phase<pg8::EpiProj, pg8::StaticOrder, false, true>(F.lds, g, S, E); }
    xcd_barrier(xb);
    { const int bx = blockIdx.x, NU = BATCH * HEADS;
      for (int u = bx; u < 2 * NU; u += F.G) { const int half = u & 1; ret_unit(F, u >> 1, half ? NCHUNK / 2 : 0, half ? NCHUNK : NCHUNK / 2); }
      unsigned* cctr = (unsigned*)(a.ws + WS_CTL) + 3520;
      for (;;) {
          __syncthreads();
          if (F.tid == 0) bst[4] = xb_add(cctr, 1u);
          __syncthreads();
          const unsigned ci = bst[4];
          if (ci >= (unsigned)(M / 128)) break;
          conv_seg16(F, (int)ci * 8 + F.wave, F.lane);
      } }
    xcd_barrier(xb);
    { pg8::Gemm g{F.MIXIN, F.Wout_t, M, D, D}; pg8::StaticOrder S; S.init(M, D, F.G, (int)blockIdx.x); pg8::EpiBf16<0> E{F.MIX, D};
      pg8::gemm_phase<pg8::EpiBf16<0>, pg8::StaticOrder, false, true>(F.lds, g, S, E); }
    xcd_barrier(xb);
    p5_postmix(F);
    xcd_barrier(xb);
    { pg8::Gemm g{F.H, F.W1_t, M, FF, D}; pg8::StaticOrder S; S.init(M, FF, F.G, (int)blockIdx.x); pg8::EpiBf16<2> E{F.BIG, FF};
      pg8::gemm_phase<pg8::EpiBf16<2>, pg8::StaticOrder, false, true>(F.lds, g, S, E); }
    xcd_barrier(xb);
    { pg8::Gemm g{F.BIG, F.W2_t, M, D, FF}; pg8::StaticOrder S; S.init(M, D, F.G, (int)blockIdx.x); pg8::EpiBf16<0> E{F.MIXIN, D};
      pg8::gemm_phase<pg8::EpiBf16<0>, pg8::StaticOrder, false, true>(F.lds, g, S, E); }
    xcd_barrier(xb);
    p8_final(F);
}

extern "C" void kernel_launch(void* const* d_in, const int* in_sizes, int n_in, void* d_out, int out_size, void* d_ws, size_t ws_size, hipStream_t stream) {
    static int grid = 0;
    if (grid == 0) {
        if (n_in != 14 || in_sizes[0] != M * D || out_size != M * D || ws_size < WS_END) { fprintf(stderr, "kernel_launch: unexpected shapes (n_in %d in0 %d out %d ws %zu)\n", n_in, n_in > 0 ? in_sizes[0] : -1, out_size, ws_size); grid = -1; return; }
        if (hipFuncSetAttribute((const void*)mk_fwd, hipFuncAttributeMaxDynamicSharedMemorySize, LDS_BYTES) != hipSuccess) { fprintf(stderr, "kernel_launch: hipFuncSetAttribute failed\n"); grid = -1; return; }
        int dev = 0, cus = 0, per_cu = 0;
        if (hipGetDevice(&dev) != hipSuccess || hipDeviceGetAttribute(&cus, hipDeviceAttributeMultiprocessorCount, dev) != hipSuccess) { fprintf(stderr, "kernel_launch: device query failed\n"); grid = -1; return; }
        if (hipOccupancyMaxActiveBlocksPerMultiprocessor(&per_cu, (const void*)mk_fwd, 512, LDS_BYTES) != hipSuccess || per_cu < 1) { fprintf(stderr, "kernel_launch: occupancy query failed (%d)\n", per_cu); grid = -1; return; }
        grid = cus;
        fprintf(stderr, "kernel_launch: %d CUs, occupancy %d per CU, grid %d\n", cus, per_cu, grid);
    }
    if (grid < 0) return;
    Args a{};
    for (int i = 0; i < 14; ++i) a.in[i] = d_in[i];
    a.out = (float*)d_out; a.ws = (unsigned char*)d_ws;
    if (hipMemsetAsync((char*)d_ws + WS_CTL, 0, 16384, stream) != hipSuccess) { fprintf(stderr, "kernel_launch: memset failed\n"); return; }
    void* args[] = {&a};
    hipError_t e = hipLaunchCooperativeKernel((const void*)mk_fwd, dim3(grid), dim3(512), args, LDS_BYTES, stream);
    if (e != hipSuccess) fprintf(stderr, "kernel_launch: cooperative launch failed: %s (grid %d)\n", hipGetErrorString(e), grid);
}
```
